# Optimizing an MI355X kernel written in HIP

```python
import math
import jax, jax.numpy as jnp
from jax import lax
import numpy as np

D_MODEL = 1024
BATCH = 16
SEQ = 2048
DEPTH = 1

CHUNK = 64
Q_BLOCK = 128
ATT_HEADS = 4
ATT_HEAD_DIM = 64
ATT_V_DIM = 2 * ATT_HEAD_DIM
ATT_WIDTH = ATT_HEADS * ATT_V_DIM
CONV_WIDTH = D_MODEL - ATT_WIDTH
CONV_GROUPS = 8
CONV_K = 3
MIX_WIDTH = ATT_WIDTH + CONV_WIDTH
IN_COLS = 3 * ATT_WIDTH + 3 * CONV_WIDTH
PEER_HEADS = 8
PEER_KEY_DIM = 256
PEER_HALF = PEER_KEY_DIM // 2
N_KEYS = 128
N_EXPERTS = N_KEYS * N_KEYS
PEER_TOPK = 16
TOKEN_BLOCK = 128
EPS = 1e-6

kernel_name = "hymba_conv_diffattn_peer_block"


def rmsnorm(x, g):
    xf = x.astype(jnp.float32)
    y = xf * lax.rsqrt(jnp.mean(xf * xf, axis=-1, keepdims=True) + EPS)
    return (y * g.astype(jnp.float32)).astype(x.dtype)


def alibi_slopes():
    h = np.arange(1, ATT_HEADS + 1, dtype=np.float32)
    return jnp.asarray(2.0 ** (-8.0 * h / ATT_HEADS), dtype=jnp.float32)


def diff_attention(q, k, v, lam):
    B, S = q.shape[0], q.shape[1]
    nb = S // Q_BLOCK
    q = (q * (ATT_HEAD_DIM ** -0.5)).reshape(B, nb, Q_BLOCK, ATT_HEADS, 2, ATT_HEAD_DIM)
    q = jnp.moveaxis(q, 1, 0)
    kpos = jnp.arange(S)
    slopes = alibi_slopes()

    def block(args):
        qb, i = args
        qpos = i * Q_BLOCK + jnp.arange(Q_BLOCK)
        s = jnp.einsum('bqhcd,bkhcd->bchqk', qb, k).astype(jnp.float32)
        dist = jnp.abs(qpos[:, None] - kpos[None, :]).astype(jnp.float32)
        bias = -slopes[:, None, None] * dist
        allowed = (kpos[None, :] // CHUNK) <= (qpos[:, None] // CHUNK)
        s = jnp.where(allowed, s + bias, -jnp.inf)
        p = jax.nn.softmax(s, axis=-1)
        a = p[:, 0] - lam * p[:, 1]
        return jnp.einsum('bhqk,bkhd->bqhd', a.astype(v.dtype), v)

    out = lax.map(block, (q, jnp.arange(nb)))
    return jnp.moveaxis(out, 0, 1).reshape(B, S, ATT_HEADS, ATT_V_DIM)


def short_conv(u, w):
    kern = w[:, None, :].astype(u.dtype)
    return lax.conv_general_dilated(
        u, kern, window_strides=(1,), padding=[(CONV_K - 1, 0)],
        dimension_numbers=('NWC', 'WIO', 'NWC'), feature_group_count=CONV_WIDTH)


def peer(h, wq, keys, u_tab, v_tab):
    B, S, D = h.shape
    T = B * S
    ht = h.reshape(T, D)
    q = (ht @ wq).reshape(T, PEER_HEADS, 2, PEER_HALF)
    sc = jnp.einsum('thpd,hpnd->thpn', q, keys).astype(jnp.float32)
    s_top, i_top = lax.top_k(sc, PEER_TOPK)
    cand = s_top[:, :, 0, :, None] + s_top[:, :, 1, None, :]
    cand_idx = i_top[:, :, 0, :, None] * N_KEYS + i_top[:, :, 1, None, :]
    cand = cand.reshape(T, PEER_HEADS, PEER_TOPK * PEER_TOPK)
    cand_idx = cand_idx.reshape(T, PEER_HEADS, PEER_TOPK * PEER_TOPK)
    best, pos = lax.top_k(cand, PEER_TOPK)
    idx = jnp.take_along_axis(cand_idx, pos, axis=-1)
    g = jax.nn.softmax(best, axis=-1)
    HK = PEER_HEADS * PEER_TOPK
    nb = T // TOKEN_BLOCK

    def block(args):
        xb, ib, gb = args
        u = u_tab[ib]
        a = jax.nn.gelu(jnp.einsum('td,ted->te', xb, u), approximate=False)
        v = v_tab[ib]
        return jnp.einsum('te,ted->td', (gb * a).astype(v.dtype), v)

    out = lax.map(block, (ht.reshape(nb, TOKEN_BLOCK, D),
                          idx.reshape(nb, TOKEN_BLOCK, HK),
                          g.reshape(nb, TOKEN_BLOCK, HK)))
    return out.reshape(B, S, D)


def setup_inputs(seed: int = 0) -> dict:
    key = jax.random.key(seed)
    ks = jax.random.split(key, 24)
    f32 = jnp.float32
    L, D = DEPTH, D_MODEL
    nrm = lambda k, shape, s: jax.random.normal(k, shape, f32) * s
    return {
        "x": nrm(ks[0], (BATCH, SEQ, D), 1.0),
        "c": nrm(ks[1], (BATCH, D), 1.0),
        "ada_w": nrm(ks[2], (L, D, 6 * D), 0.5 * D ** -0.5),
        "ada_b": nrm(ks[3], (L, 6 * D), 0.02),
        "norm1_g": 1.0 + nrm(ks[4], (L, D), 0.02),
        "w_in": nrm(ks[5], (L, D, IN_COLS), D ** -0.5),
        "conv_w": nrm(ks[6], (L, CONV_K, CONV_WIDTH), CONV_K ** -0.5),
        "lam_q1": nrm(ks[7], (L, ATT_HEAD_DIM), 0.1),
        "lam_k1": nrm(ks[8], (L, ATT_HEAD_DIM), 0.1),
        "lam_q2": nrm(ks[9], (L, ATT_HEAD_DIM), 0.1),
        "lam_k2": nrm(ks[10], (L, ATT_HEAD_DIM), 0.1),
        "attn_norm_g": 1.0 + nrm(ks[11], (L, ATT_WIDTH), 0.02),
        "conv_norm_g": 1.0 + nrm(ks[12], (L, CONV_WIDTH), 0.02),
        "w_o": nrm(ks[13], (L, MIX_WIDTH, D), MIX_WIDTH ** -0.5),
        "norm2_g": 1.0 + nrm(ks[14], (L, D), 0.02),
        "peer_wq": nrm(ks[15], (L, D, PEER_HEADS * PEER_KEY_DIM), D ** -0.5),
        "peer_keys": nrm(ks[16], (L, PEER_HEADS, 2, N_KEYS, PEER_HALF), PEER_HALF ** -0.5),
        "peer_u": nrm(ks[17], (L, N_EXPERTS, D), D ** -0.5),
        "peer_v": nrm(ks[18], (L, N_EXPERTS, D), PEER_HEADS ** -0.5),
        "final_g": 1.0 + nrm(ks[19], (D,), 0.02),
    }


def reference(x, c, ada_w, ada_b, norm1_g, w_in, conv_w, lam_q1, lam_k1, lam_q2, lam_k2,
              attn_norm_g, conv_norm_g, w_o, norm2_g, peer_wq, peer_keys, peer_u, peer_v,
              final_g):
    B, S, D = x.shape
    split_at = [ATT_WIDTH, 2 * ATT_WIDTH, 3 * ATT_WIDTH,
                3 * ATT_WIDTH + CONV_WIDTH, 3 * ATT_WIDTH + 2 * CONV_WIDTH]
    for l in range(DEPTH):
        mod = jax.nn.silu(c) @ ada_w[l] + ada_b[l]
        sh1, sc1, g1, sh2, sc2, g2 = jnp.split(mod[:, None, :], 6, axis=-1)

        h = rmsnorm(x, norm1_g[l]) * (1.0 + sc1) + sh1
        p = h @ w_in[l]
        q, k, v, cb, cc, ch = jnp.split(p, split_at, axis=-1)
        q = q.reshape(B, S, ATT_HEADS, 2, ATT_HEAD_DIM)
        k = k.reshape(B, S, ATT_HEADS, 2, ATT_HEAD_DIM)
        v = v.reshape(B, S, ATT_HEADS, ATT_V_DIM)

        lam_init = 0.8 - 0.6 * math.exp(-0.3 * l)
        lam = (jnp.exp(jnp.sum(lam_q1[l].astype(jnp.float32) * lam_k1[l].astype(jnp.float32)))
               - jnp.exp(jnp.sum(lam_q2[l].astype(jnp.float32) * lam_k2[l].astype(jnp.float32)))
               + lam_init)
        att = diff_attention(q, k, v, lam)
        att = rmsnorm(att, attn_norm_g[l].reshape(ATT_HEADS, ATT_V_DIM)) * (1.0 - lam_init)
        att = att.reshape(B, S, ATT_WIDTH)

        cv = cb * short_conv(cc * ch, conv_w[l])
        cv = rmsnorm(cv, conv_norm_g[l])

        mix = jnp.concatenate([att, cv], axis=-1) @ w_o[l]
        x = x + g1 * mix

        h2 = rmsnorm(x, norm2_g[l]) * (1.0 + sc2) + sh2
        x = x + g2 * peer(h2, peer_wq[l], peer_keys[l], peer_u[l], peer_v[l])
    return rmsnorm(x, final_g)
```

```cpp
#include <hip/hip_runtime.h>
#include <hip/hip_bf16.h>
#include <cstdio>
#include <cstdint>
#include <cmath>

#ifndef MK_N_LAUNCHES
#define MK_N_LAUNCHES 10
#endif

namespace pg8 {
#define PG8_LAS __attribute__((address_space(3)))
typedef unsigned short bf16_t;
typedef short bf16x8 __attribute__((ext_vector_type(8)));
typedef float f32x4 __attribute__((ext_vector_type(4)));
typedef unsigned u32x4 __attribute__((ext_vector_type(4)));
constexpr int BM = 256, BK = 64, HALF = 128, HTB = HALF * BK * 2  , STAGE_BYTES = 8 * HTB, NXCD = 8, WGM = 8;

__host__ __device__ __forceinline__ int lds_byte(int r, int c) { const int st = (r >> 4) * 2 + (c >> 5), rr = r & 15, cc = c & 31, ob = rr * 64 + cc * 2; return st * 1024 + (ob ^ (((ob >> 9) & 1) << 5)); }
__host__ __device__ __forceinline__ void stage_rc(int b, int& R, int& C) { const int st = b / 1024, sb = b % 1024, swz = sb ^ (((sb >> 9) & 1) << 5); R = (st >> 1) * 16 + swz / 64; C = (st & 1) * 32 + (swz % 64) / 2; }
__host__ __device__ __forceinline__ int perm32(int rho) { const int n = rho >> 4, i = rho & 15; return 8 * (i >> 2) + 4 * n + (i & 3); }

struct Unit { int pm, pn; };
struct Gemm { const bf16_t* A; const bf16_t* Bt; int M, N, K; };

struct StaticOrder {
    int nM, nN, nwg, G, c;
    __host__ __device__ void init(int M, int N, int G_, int c_) { nM = M / BM; nN = N / BM; nwg = nM * nN; G = G_; c = c_; }
    __host__ __device__ bool next(int i, Unit& u) const {
        const long L = (long)i * G + c; if (L >= nwg) return false;
        int wgid = (int)L; { const int q = nwg / NXCD, r = nwg % NXCD, xcd = wgid % NXCD, off = wgid / NXCD; wgid = (xcd < r ? xcd * (q + 1) : r * (q + 1) + (xcd - r) * q) + off; }
        const int nig = WGM * nN, gid = wgid / nig, fm = gid * WGM, gsz = (nM - fm) < WGM ? (nM - fm) : WGM;
        u.pm = fm + ((wgid % nig) % gsz); u.pn = (wgid % nig) / gsz; return true;
    }
    __device__ __forceinline__ void a_ready(const Unit&) const {}
    __device__ __forceinline__ void done(const Unit&) const {}
};

__device__ __forceinline__ unsigned cvt_pk_bf16(float lo, float hi) { unsigned r; asm volatile("v_cvt_pk_bf16_f32 %0, %1, %2" : "=v"(r) : "v"(lo), "v"(hi)); return r; }
struct EpiP {
    static constexpr bool PERM = true, AFTER_DRAIN = false;
    bf16_t *Q, *K, *V, *CB, *GC; float qscale;
    __device__ __forceinline__ void operator()(const f32x4 (&acc)[2][2][4][2], const Unit& u, int wr, int wc, int fr, int fq) const {
        const int row0 = u.pm * BM + wr * 64 + fr;
        if (u.pn < 8) {
            const int sel = u.pn >> 1; bf16_t* base = sel == 0 ? Q : (sel == 1 ? K : (sel == 2 ? V : CB));
            const float sc = sel == 0 ? qscale : 1.f; const int col0 = (u.pn & 1) * 256 + wc * 32 + 8 * fq;
#pragma unroll
            for (int ai = 0; ai < 2; ++ai)
#pragma unroll
                for (int m = 0; m < 4; ++m) { bf16_t* rowp = base + (size_t)(row0 + ai * HALF + m * 16) * 512 + col0;
#pragma unroll
                    for (int bj = 0; bj < 2; ++bj) { const f32x4 v0 = acc[ai][bj][m][0] * sc, v1 = acc[ai][bj][m][1] * sc;
                        u32x4 w; w.x = cvt_pk_bf16(v0[0], v0[1]); w.y = cvt_pk_bf16(v0[2], v0[3]); w.z = cvt_pk_bf16(v1[0], v1[1]); w.w = cvt_pk_bf16(v1[2], v1[3]);
                        *(u32x4*)(rowp + bj * HALF) = w; } }
        } else {
            const int col0 = (u.pn - 8) * 128 + wc * 32 + 8 * fq;
#pragma unroll
            for (int ai = 0; ai < 2; ++ai)
#pragma unroll
                for (int m = 0; m < 4; ++m) { bf16_t* rowp = GC + (size_t)(row0 + ai * HALF + m * 16) * 512 + col0;
                    const f32x4 v0 = acc[ai][0][m][0] * acc[ai][1][m][0], v1 = acc[ai][0][m][1] * acc[ai][1][m][1];
                    u32x4 w; w.x = cvt_pk_bf16(v0[0], v0[1]); w.y = cvt_pk_bf16(v0[2], v0[3]); w.z = cvt_pk_bf16(v1[0], v1[1]); w.w = cvt_pk_bf16(v1[2], v1[3]);
                    *(u32x4*)rowp = w; }
        }
    }
};
struct EpiRes {
    static constexpr bool PERM = false, AFTER_DRAIN = false;
    const float* x; float* x1; const float* MOD; float* SS;
    __device__ __forceinline__ void operator()(const f32x4 (&acc)[2][2][4][2], const Unit& u, int wr, int wc, int fr, int fq) const {
        const int row0 = u.pm * BM + wr * 64 + fr, col0 = u.pn * BM + wc * 32 + 4 * fq; const int b = u.pm >> 3;
        f32x4 gv[2][2];
#pragma unroll
        for (int bj = 0; bj < 2; ++bj)
#pragma unroll
            for (int n = 0; n < 2; ++n) gv[bj][n] = *(const f32x4*)(MOD + (size_t)b * 6144 + 2048 + col0 + bj * HALF + n * 16);
#pragma unroll
        for (int ai = 0; ai < 2; ++ai)
#pragma unroll
            for (int m = 0; m < 4; ++m) { const int row = row0 + ai * HALF + m * 16; const size_t off = (size_t)row * 1024 + col0; float s = 0.f;
#pragma unroll
                for (int bj = 0; bj < 2; ++bj)
#pragma unroll
                    for (int n = 0; n < 2; ++n) { const f32x4 xv = *(const f32x4*)(x + off + bj * HALF + n * 16); const f32x4 o = xv + gv[bj][n] * acc[ai][bj][m][n];
                        *(f32x4*)(x1 + off + bj * HALF + n * 16) = o; s += (o[0] * o[0] + o[1] * o[1]) + (o[2] * o[2] + o[3] * o[3]); }
                s += __shfl_xor(s, 16); s += __shfl_xor(s, 32);
                if (fq == 0) SS[(size_t)row * 16 + u.pn * 4 + wc] = s; }
    }
};
struct EpiF32 {
    static constexpr bool PERM = false, AFTER_DRAIN = false;
    float* C; int ldc;
    __device__ __forceinline__ void operator()(const f32x4 (&acc)[2][2][4][2], const Unit& u, int wr, int wc, int fr, int fq) const {
        const int row0 = u.pm * BM + wr * 64 + fr, col0 = u.pn * BM + wc * 32 + 4 * fq;
#pragma unroll
        for (int ai = 0; ai < 2; ++ai)
#pragma unroll
            for (int m = 0; m < 4; ++m) { float* rowp = C + (size_t)(row0 + ai * HALF + m * 16) * ldc + col0;
#pragma unroll
                for (int bj = 0; bj < 2; ++bj)
#pragma unroll
                    for (int n = 0; n < 2; ++n) *(f32x4*)(rowp + bj * HALF + n * 16) = acc[ai][bj][m][n]; }
    }
};

template <class Epi, class Sched, bool ALIGN_EPI = false, bool SP2 = false>
__device__ __forceinline__ void gemm_phase(PG8_LAS unsigned char* lds, const Gemm g, const Sched& S, const Epi& E) {
    const int tid = threadIdx.x, wid = __builtin_amdgcn_readfirstlane(tid >> 6), lane = tid & 63, wr = wid >> 2, wc = wid & 3, fr = lane & 15, fq = lane >> 4;
    const int K = g.K, nt = K / BK;
    unsigned voffA[2], voffB[2];
#pragma unroll
    for (int i = 0; i < 2; ++i) { int R, C; stage_rc(tid * 16 + i * 8192, R, C); const int Rb = Epi::PERM ? ((R & ~31) + perm32(R & 31)) : R;
        voffA[i] = (unsigned)(R * K + C) * 2u; voffB[i] = (unsigned)(Rb * K + C) * 2u; }
    const size_t kstep = (size_t)(BK * 2);
    const size_t hstep = (size_t)HALF * K * 2;
    const size_t tstep = 2 * hstep;
    const unsigned ldsw = (unsigned)wid * 1024u;
    const int aoff = lds_byte(wr * 64 + fr, fq * 8), boff = lds_byte(wc * 32 + fr, fq * 8);
#define PG8_SA(b, h) (((b) * 2 + (h)) * HTB)
#define PG8_SB(b, h) ((4 + (b) * 2 + (h)) * HTB)
#define PG8_STAGE(bufoff, gbase, voff) do { _Pragma("unroll") for (int _i = 0; _i < 2; ++_i) \
        __builtin_amdgcn_global_load_lds((const unsigned*)((const char*)(gbase) + (voff)[_i]), (PG8_LAS unsigned*)(lds + (bufoff) + ldsw + _i * 8192), 16, 0, 0); } while (0)
#define PG8_LDA(dst, b, h) do { _Pragma("unroll") for (int m = 0; m < 4; ++m) _Pragma("unroll") for (int k = 0; k < 2; ++k) dst[m][k] = *(const PG8_LAS bf16x8*)(lds + PG8_SA(b, h) + aoff + m * 2048 + k * 1024); } while (0)
#define PG8_LDB(dst, b, h) do { _Pragma("unroll") for (int n = 0; n < 2; ++n) _Pragma("unroll") for (int k = 0; k < 2; ++k) dst[n][k] = *(const PG8_LAS bf16x8*)(lds + PG8_SB(b, h) + boff + n * 2048 + k * 1024); } while (0)
#define PG8_MMA(ai, bj, At, Bt) do { __builtin_amdgcn_s_setprio(1); _Pragma("unroll") for (int m = 0; m < 4; ++m) _Pragma("unroll") for (int n = 0; n < 2; ++n) _Pragma("unroll") for (int k = 0; k < 2; ++k) \
        acc[ai][bj][m][n] = __builtin_amdgcn_mfma_f32_16x16x32_bf16(Bt[n][k], At[m][k], acc[ai][bj][m][n], 0, 0, 0); __builtin_amdgcn_s_setprio(0); } while (0)
#define PG8_WAIT_V(n) asm volatile("s_waitcnt vmcnt(" #n ")" ::: "memory")
#define PG8_WAIT_L(n) asm volatile("s_waitcnt lgkmcnt(" #n ")" ::: "memory")
#define PG8_BAR __builtin_amdgcn_s_barrier()
#define PG8_SCHED __builtin_amdgcn_sched_barrier(0)
    Unit cur, nxt; int ui = 0;
    if (!S.next(0, cur)) return;
    f32x4 acc[2][2][4][2];
#pragma unroll
    for (int a = 0; a < 2; ++a)
#pragma unroll
        for (int b = 0; b < 2; ++b)
#pragma unroll
            for (int m = 0; m < 4; ++m)
#pragma unroll
                for (int n = 0; n < 2; ++n) acc[a][b][m][n] = (f32x4){0.f, 0.f, 0.f, 0.f};
    bf16x8 At[4][2], B0[2][2], B1[2][2];
    const char* cA = (const char*)g.A + (size_t)cur.pm * tstep; const char* cB = (const char*)g.Bt + (size_t)cur.pn * tstep;
    S.a_ready(cur);
    if constexpr (SP2) {
        PG8_STAGE(PG8_SB(0, 0), cB, voffB); PG8_STAGE(PG8_SB(0, 1), cB + hstep, voffB); PG8_STAGE(PG8_SA(0, 0), cA, voffA); PG8_STAGE(PG8_SA(0, 1), cA + hstep, voffA);
        if (wr == 1) PG8_BAR;
        PG8_WAIT_V(2); PG8_BAR;
        PG8_STAGE(PG8_SB(1, 0), cB + kstep, voffB); PG8_STAGE(PG8_SA(1, 0), cA + kstep, voffA); PG8_STAGE(PG8_SB(1, 1), cB + hstep + kstep, voffB);
        PG8_WAIT_V(6); PG8_BAR;
    } else {
        PG8_STAGE(PG8_SB(0, 0), cB, voffB); PG8_STAGE(PG8_SA(0, 0), cA, voffA); PG8_STAGE(PG8_SB(0, 1), cB + hstep, voffB); PG8_STAGE(PG8_SA(0, 1), cA + hstep, voffA);
        if (wr == 1) PG8_BAR;
        PG8_WAIT_V(4); PG8_BAR;
        PG8_STAGE(PG8_SB(1, 0), cB + kstep, voffB); PG8_STAGE(PG8_SA(1, 0), cA + kstep, voffA); PG8_STAGE(PG8_SB(1, 1), cB + hstep + kstep, voffB);
        PG8_WAIT_V(6); PG8_BAR;
    }
    for (;;) {
        const bool has_next = S.next(ui + 1, nxt);
        const char* nA = has_next ? (const char*)g.A + (size_t)nxt.pm * tstep : cA; const char* nB = has_next ? (const char*)g.Bt + (size_t)nxt.pn * tstep : cB;
        for (int t = 0; t < nt; t += 2) {
            const bool last = (t == nt - 2);
            const char* a1 = cA + (size_t)(t + 1) * kstep;
            const char* a2 = last ? nA : cA + (size_t)(t + 2) * kstep; const char* b2 = last ? nB : cB + (size_t)(t + 2) * kstep;
            const char* a3 = a2 + kstep; const char* b3 = b2 + kstep;
            if (last && has_next) S.a_ready(nxt);
            if constexpr (SP2) {
            PG8_LDB(B0, 0, 0); PG8_LDB(B1, 0, 1); PG8_SCHED; PG8_LDA(At, 0, 0); PG8_STAGE(PG8_SA(1, 1), a1 + hstep, voffA);
            PG8_WAIT_V(8); PG8_WAIT_L(0); PG8_BAR; PG8_MMA(0, 0, At, B0); PG8_MMA(0, 1, At, B1); PG8_BAR; PG8_SCHED;
            PG8_LDA(At, 0, 1); PG8_STAGE(PG8_SB(0, 0), b2, voffB); PG8_STAGE(PG8_SB(0, 1), b2 + hstep, voffB); PG8_STAGE(PG8_SA(0, 0), a2, voffA);
            PG8_WAIT_V(8); PG8_WAIT_L(0); PG8_BAR; PG8_MMA(1, 0, At, B0); PG8_MMA(1, 1, At, B1); PG8_BAR; PG8_SCHED;
            PG8_LDB(B0, 1, 0); PG8_LDB(B1, 1, 1); PG8_SCHED; PG8_LDA(At, 1, 0); PG8_STAGE(PG8_SA(0, 1), a2 + hstep, voffA);
            PG8_WAIT_V(8); PG8_WAIT_L(0); PG8_BAR; PG8_MMA(0, 0, At, B0); PG8_MMA(0, 1, At, B1); PG8_BAR; PG8_SCHED;
            PG8_LDA(At, 1, 1); PG8_STAGE(PG8_SB(1, 0), b3, voffB); PG8_STAGE(PG8_SB(1, 1), b3 + hstep, voffB); PG8_STAGE(PG8_SA(1, 0), a3, voffA);
            PG8_WAIT_V(8); PG8_WAIT_L(0); PG8_BAR; PG8_MMA(1, 0, At, B0); PG8_MMA(1, 1, At, B1); PG8_BAR; PG8_SCHED;
            } else {
            PG8_LDB(B0, 0, 0); PG8_SCHED; PG8_LDA(At, 0, 0); PG8_STAGE(PG8_SA(1, 1), a1 + hstep, voffA);
            PG8_WAIT_L(8); PG8_BAR; PG8_WAIT_L(0); PG8_MMA(0, 0, At, B0); PG8_BAR; PG8_SCHED;
            PG8_LDB(B1, 0, 1); PG8_STAGE(PG8_SB(0, 0), b2, voffB);
            PG8_BAR; PG8_WAIT_L(0); PG8_MMA(0, 1, At, B1); PG8_BAR;
            PG8_LDA(At, 0, 1); PG8_STAGE(PG8_SA(0, 0), a2, voffA);
            PG8_BAR; PG8_WAIT_L(0); PG8_MMA(1, 0, At, B0); PG8_BAR; PG8_SCHED;
            PG8_STAGE(PG8_SB(0, 1), b2 + hstep, voffB);
            PG8_WAIT_V(6); PG8_BAR; PG8_MMA(1, 1, At, B1); PG8_BAR;
            PG8_LDB(B0, 1, 0); PG8_SCHED; PG8_LDA(At, 1, 0); PG8_STAGE(PG8_SA(0, 1), a2 + hstep, voffA);
            PG8_WAIT_L(8); PG8_BAR; PG8_WAIT_L(0); PG8_MMA(0, 0, At, B0); PG8_BAR; PG8_SCHED;
            PG8_LDB(B1, 1, 1); PG8_STAGE(PG8_SB(1, 0), b3, voffB);
            PG8_BAR; PG8_WAIT_L(0); PG8_MMA(0, 1, At, B1); PG8_BAR;
            PG8_LDA(At, 1, 1); PG8_STAGE(PG8_SA(1, 0), a3, voffA);
            PG8_BAR; PG8_WAIT_L(0); PG8_MMA(1, 0, At, B0); PG8_BAR; PG8_SCHED;
            PG8_STAGE(PG8_SB(1, 1), b3 + hstep, voffB);
            PG8_WAIT_V(6); PG8_BAR; PG8_MMA(1, 1, At, B1); PG8_BAR;
            }
        }
        if constexpr (ALIGN_EPI) { if (wr == 0) PG8_BAR; }
        if constexpr (!Epi::AFTER_DRAIN) { E(acc, cur, wr, wc, fr, fq); S.done(cur); }
        if (!has_next) break;
#pragma unroll
        for (int a = 0; a < 2; ++a)
#pragma unroll
            for (int b = 0; b < 2; ++b)
#pragma unroll
                for (int m = 0; m < 4; ++m)
#pragma unroll
                    for (int n = 0; n < 2; ++n) acc[a][b][m][n] = (f32x4){0.f, 0.f, 0.f, 0.f};
        cur = nxt; cA = nA; cB = nB; ++ui;
        if constexpr (ALIGN_EPI) { if (wr == 1) PG8_BAR; }
    }
    PG8_WAIT_V(0);
    if constexpr (!ALIGN_EPI) { if (wr == 0) PG8_BAR; }
    PG8_BAR;
    if constexpr (Epi::AFTER_DRAIN) { E.fused(acc, cur, wr, wc, fr, fq, lds, wid, lane); S.done(cur); }
#undef PG8_SA
#undef PG8_SB
#undef PG8_STAGE
#undef PG8_LDA
#undef PG8_LDB
#undef PG8_MMA
#undef PG8_WAIT_V
#undef PG8_WAIT_L
#undef PG8_BAR
#undef PG8_SCHED
}
}
namespace att {
using bf16x8 = __attribute__((ext_vector_type(8))) short;
using s16x4  = __attribute__((ext_vector_type(4))) short;
using f32x16 = __attribute__((ext_vector_type(16))) float;
using f32x4  = __attribute__((ext_vector_type(4))) float;
using u32x4  = __attribute__((ext_vector_type(4))) unsigned;
typedef unsigned short bf16_t;
constexpr int S = 2048, PITCH = 512, SHM_K = 16384, SHM_V = 16384;
constexpr int OFF_XO = 0, XO_LD = 132, OFF_WS = 69632, LDS_BYTES = OFF_WS + 8 * 64 * 4;
constexpr float THR = 8.f;
#define KSWZ(row, colB) ((row) * 256 + ((colB) ^ (((row) & 7) << 4)))
#define SBAR() __builtin_amdgcn_sched_barrier(0)
__device__ __forceinline__ int crow(int r, int hi) { return (r & 3) + 8 * (r >> 2) + 4 * hi; }
__device__ __forceinline__ unsigned cvtpk(float lo, float hi) { unsigned r; asm volatile("v_cvt_pk_bf16_f32 %0, %1, %2" : "=v"(r) : "v"(lo), "v"(hi)); return r; }
__device__ __forceinline__ int v_st(int k, int c) { const int kk = (k & ~0xC) | ((k & 4) << 1) | ((k & 8) >> 1); return ((kk >> 3) * 4 + (c >> 5)) * 512 + ((kk & 7) * 32 + (c & 31)) * 2; }
__device__ __forceinline__ int v_rd_base(int lane) { return ((lane & 3) << 3) | (((lane >> 2) & 3) << 6) | (((lane >> 4) & 1) << 5) | (((lane >> 5) & 1) << 8); }
constexpr int v_rd_off(int d0, int ks, int half) { return d0 * 512 + ks * 4096 + half * 2048; }
template <int OFF> __device__ __forceinline__ s16x4 tr_read(int vb) { s16x4 r; asm volatile("ds_read_b64_tr_b16 %0, %1 offset:%2" : "=&v"(r) : "v"(vb), "i"(OFF) : "memory"); return r; }
template <int D0> __device__ __forceinline__ void pv_one(f32x16& od, int vb, bf16x8 pa0, bf16x8 pa1, bf16x8 pa2, bf16x8 pa3) {
  const s16x4 l0 = tr_read<v_rd_off(D0, 0, 0)>(vb), h0 = tr_read<v_rd_off(D0, 0, 1)>(vb), l1 = tr_read<v_rd_off(D0, 1, 0)>(vb), h1 = tr_read<v_rd_off(D0, 1, 1)>(vb);
  const s16x4 l2 = tr_read<v_rd_off(D0, 2, 0)>(vb), h2 = tr_read<v_rd_off(D0, 2, 1)>(vb), l3 = tr_read<v_rd_off(D0, 3, 0)>(vb), h3 = tr_read<v_rd_off(D0, 3, 1)>(vb);
  asm volatile("s_waitcnt lgkmcnt(0)" ::: "memory"); SBAR();
#define PKV(L, H) (bf16x8){L[0], L[1], L[2], L[3], H[0], H[1], H[2], H[3]}
  od = __builtin_amdgcn_mfma_f32_32x32x16_bf16(pa0, PKV(l0, h0), od, 0, 0, 0);
  od = __builtin_amdgcn_mfma_f32_32x32x16_bf16(pa1, PKV(l1, h1), od, 0, 0, 0);
  od = __builtin_amdgcn_mfma_f32_32x32x16_bf16(pa2, PKV(l2, h2), od, 0, 0, 0);
  od = __builtin_amdgcn_mfma_f32_32x32x16_bf16(pa3, PKV(l3, h3), od, 0, 0, 0);
#undef PKV
}
__device__ __forceinline__ void pv_d0(f32x16* o, int vb, bf16x8 pa0, bf16x8 pa1, bf16x8 pa2, bf16x8 pa3) {
  pv_one<0>(o[0], vb, pa0, pa1, pa2, pa3); pv_one<1>(o[1], vb, pa0, pa1, pa2, pa3); pv_one<2>(o[2], vb, pa0, pa1, pa2, pa3); pv_one<3>(o[3], vb, pa0, pa1, pa2, pa3);
}

__device__ __forceinline__ void attn_unit(int b, int h, int u, const bf16_t* __restrict__ Q, const bf16_t* __restrict__ K, const bf16_t* __restrict__ V, bf16_t* __restrict__ MIX,
                                          const float* __restrict__ gnorm, float lam, float sl2, char* lds) {
  int tid_ = threadIdx.x; asm volatile("" : "+v"(tid_));
  const int tid = tid_, lane = tid & 63, r32 = lane & 31, hi = lane >> 5;
  const int wid = __builtin_amdgcn_readfirstlane(tid >> 6);
  const int c = wid >> 2, rb = wid & 3;
  const int q0 = u * 128, mychunk = 2 * u + (rb >> 1), NT = 2 * u + 2;
  const int qpos = q0 + rb * 32 + r32;
  const size_t rowbase = (size_t)b * S;
  char* V_lds = lds; char* K_lds = lds + 2 * SHM_V;
  float* ws = (float*)(lds + OFF_WS) + wid * 64;
  bf16x8 qr[4];
  { const bf16_t* Qw = Q + (rowbase + qpos) * PITCH + h * 128 + c * 64 + hi * 8;
#pragma unroll
    for (int d0 = 0; d0 < 4; ++d0) qr[d0] = *reinterpret_cast<const bf16x8*>(Qw + d0 * 16); }
  const int sr = tid >> 4, sc = (tid & 15) * 8;
  const int vst0 = v_st(sr, sc), vst1 = v_st(32 + sr, sc);
  const int kst0 = KSWZ(sr, sc * 2), kst1 = KSWZ(32 + sr, sc * 2);
  const int vb0 = (int)(uintptr_t)V_lds + v_rd_base(lane);
  const bf16_t* Kg = K + rowbase * PITCH + h * 128 + sc; const bf16_t* Vg = V + rowbase * PITCH + h * 128 + sc;
  bf16x8 vs0, vs1, ks0, ks1;
#define SLOAD(k0) do { vs0 = *reinterpret_cast<const bf16x8*>(Vg + (size_t)((k0) + sr) * PITCH); vs1 = *reinterpret_cast<const bf16x8*>(Vg + (size_t)((k0) + 32 + sr) * PITCH); \
    ks0 = *reinterpret_cast<const bf16x8*>(Kg + (size_t)((k0) + sr) * PITCH); ks1 = *reinterpret_cast<const bf16x8*>(Kg + (size_t)((k0) + 32 + sr) * PITCH); } while (0)
#define SWRITE(bf) do { *(bf16x8*)(V_lds + (bf) * SHM_V + vst0) = vs0; *(bf16x8*)(V_lds + (bf) * SHM_V + vst1) = vs1; \
    *(bf16x8*)(K_lds + (bf) * SHM_K + kst0) = ks0; *(bf16x8*)(K_lds + (bf) * SHM_K + kst1) = ks1; } while (0)
  float m = 0.f, l = 0.f; f32x16 o[4];
#pragma unroll
  for (int d = 0; d < 4; ++d) o[d] = f32x16{};
  bool started = false;
  SLOAD((NT - 1) * 64); SWRITE(0); __syncthreads();
#pragma unroll 1
  for (int it = 0; it < NT; ++it) {
    const int j = NT - 1 - it, bf = it & 1;
    if (it + 1 < NT) SLOAD((j - 1) * 64);
    if (j <= mychunk) {
      f32x16 p0, p1;
      if (j != mychunk) { const float t0 = sl2 * (float)(64 * j + 4 * hi - qpos) - m;
#pragma unroll
        for (int r = 0; r < 16; ++r) { p0[r] = fmaf(sl2, (float)((r & 3) + 8 * (r >> 2)), t0); p1[r] = p0[r] + 32.f * sl2; } }
      else {
#pragma unroll
        for (int r = 0; r < 16; ++r) { const float d = (float)(64 * j + crow(r, hi) - qpos); p0[r] = -sl2 * fabsf(d) - m; p1[r] = -sl2 * fabsf(d + 32.f) - m; } }
      const char* Kb = K_lds + bf * SHM_K;
#pragma unroll
      for (int d0 = 0; d0 < 4; ++d0) { const int cbb = ((c * 4 + d0) * 16 + hi * 8) * 2;
        const bf16x8 b0 = *reinterpret_cast<const bf16x8*>(Kb + KSWZ(r32, cbb));
        const bf16x8 b1 = *reinterpret_cast<const bf16x8*>(Kb + KSWZ(32 + r32, cbb));
        p0 = __builtin_amdgcn_mfma_f32_32x32x16_bf16(b0, qr[d0], p0, 0, 0, 0);
        p1 = __builtin_amdgcn_mfma_f32_32x32x16_bf16(b1, qr[d0], p1, 0, 0, 0); }
      float pmax = p0[0];
#pragma unroll
      for (int r = 1; r < 16; ++r) pmax = fmaxf(pmax, p0[r]);
#pragma unroll
      for (int r = 0; r < 16; ++r) pmax = fmaxf(pmax, p1[r]);
      { auto rr = __builtin_amdgcn_permlane32_swap(__float_as_uint(pmax), __float_as_uint(pmax), false, false); pmax = fmaxf(__uint_as_float(rr[0]), __uint_as_float(rr[1])); }
      if (!started) { started = true; m += pmax;
#pragma unroll
        for (int r = 0; r < 16; ++r) { p0[r] -= pmax; p1[r] -= pmax; } }
      else if (__any(pmax > THR)) { const float delta = fmaxf(pmax, 0.f); m += delta;
#pragma unroll
        for (int r = 0; r < 16; ++r) { p0[r] -= delta; p1[r] -= delta; }
        const float alpha = __builtin_amdgcn_exp2f(-delta); l *= alpha;
        if (hi == 0) ws[r32] = alpha;
        asm volatile("s_waitcnt lgkmcnt(0)" ::: "memory");
#pragma unroll
        for (int r = 0; r < 16; ++r) { const float a = ws[crow(r, hi)];
#pragma unroll
          for (int d = 0; d < 4; ++d) o[d][r] *= a; } }
#pragma unroll
      for (int r = 0; r < 16; ++r) { p0[r] = __builtin_amdgcn_exp2f(p0[r]); p1[r] = __builtin_amdgcn_exp2f(p1[r]); }
      float ps = 0.f;
#pragma unroll
      for (int r = 0; r < 16; ++r) ps += p0[r];
#pragma unroll
      for (int r = 0; r < 16; ++r) ps += p1[r];
      { auto rr = __builtin_amdgcn_permlane32_swap(__float_as_uint(ps), __float_as_uint(ps), false, false); ps = __uint_as_float(rr[0]) + __uint_as_float(rr[1]); }
      l += ps;
      bf16x8 pa0, pa1, pa2, pa3;
#define PK4(P, BASE, OUT) do { unsigned a0 = cvtpk(P[BASE + 0], P[BASE + 1]), a1 = cvtpk(P[BASE + 2], P[BASE + 3]);   \
    unsigned b0_ = cvtpk(P[BASE + 4], P[BASE + 5]), b1_ = cvtpk(P[BASE + 6], P[BASE + 7]);                              \
    auto r0 = __builtin_amdgcn_permlane32_swap(a0, b0_, false, false); auto r1 = __builtin_amdgcn_permlane32_swap(a1, b1_, false, false); \
    u32x4 w = {r0[0], r1[0], r0[1], r1[1]}; OUT = __builtin_bit_cast(bf16x8, w); } while (0)
      PK4(p0, 0, pa0); PK4(p0, 8, pa1); PK4(p1, 0, pa2); PK4(p1, 8, pa3);
#undef PK4
      pv_d0(o, vb0 + bf * SHM_V, pa0, pa1, pa2, pa3);
    }
    if (it + 1 < NT) SWRITE(bf ^ 1);
    __syncthreads();
  }
#undef SLOAD
#undef SWRITE
  if (hi == 0) ws[r32] = l;
  asm volatile("s_waitcnt lgkmcnt(0)" ::: "memory");
  float rli[16];
#pragma unroll
  for (int r = 0; r < 16; ++r) rli[r] = 1.f / ws[crow(r, hi)];
  float* XO = (float*)(lds + OFF_XO) + rb * (32 * XO_LD);
  if (c == 1) {
#pragma unroll
    for (int r = 0; r < 16; ++r)
#pragma unroll
      for (int d0 = 0; d0 < 4; ++d0) XO[crow(r, hi) * XO_LD + d0 * 32 + r32] = lam * o[d0][r] * rli[r];
  }
  __syncthreads();
  if (c == 0) {
#pragma unroll
    for (int r = 0; r < 16; ++r)
#pragma unroll
      for (int d0 = 0; d0 < 4; ++d0) { float* p = &XO[crow(r, hi) * XO_LD + d0 * 32 + r32]; *p = o[d0][r] * rli[r] - *p; }
    asm volatile("s_waitcnt lgkmcnt(0)" ::: "memory");
    const int row = lane >> 1, half = lane & 1; const float* rp = XO + row * XO_LD + half * 64;
    f32x4 v[16]; float ss = 0.f;
#pragma unroll
    for (int i = 0; i < 16; ++i) { v[i] = *(const f32x4*)(rp + 4 * i); ss += (v[i][0] * v[i][0] + v[i][1] * v[i][1]) + (v[i][2] * v[i][2] + v[i][3] * v[i][3]); }
    ss += __shfl_xor(ss, 1);
    const float rn = 0.8f / sqrtf(ss * (1.f / 128.f) + 1e-6f);
    bf16_t* op = MIX + (rowbase + q0 + rb * 32 + row) * 1024 + h * 128 + half * 64;
    const float* gp = gnorm + half * 64;
#pragma unroll
    for (int k = 0; k < 8; ++k) { const f32x4 ga = *(const f32x4*)(gp + 8 * k), gb = *(const f32x4*)(gp + 8 * k + 4); const f32x4 a = v[2 * k] * ga * rn, bq = v[2 * k + 1] * gb * rn;
      u32x4 w; w.x = cvtpk(a[0], a[1]); w.y = cvtpk(a[2], a[3]); w.z = cvtpk(bq[0], bq[1]); w.w = cvtpk(bq[2], bq[3]); *(u32x4*)(op + 8 * k) = w; }
  }
  __syncthreads();
}
#undef KSWZ
#undef SBAR
}

#define GAS __attribute__((address_space(1)))
#define LAS __attribute__((address_space(3)))
typedef unsigned short bf16;
typedef unsigned v4u __attribute__((ext_vector_type(4)));
typedef float f32x4 __attribute__((ext_vector_type(4)));
typedef short bf16x8 __attribute__((ext_vector_type(8)));
typedef GAS unsigned gu32;
typedef GAS unsigned long long gu64;
#define RLX_AGENT __ATOMIC_RELAXED, __HIP_MEMORY_SCOPE_AGENT
#define LDS_WAIT() asm volatile("s_waitcnt lgkmcnt(0)" ::: "memory")
#define VM_WAIT() asm volatile("s_waitcnt vmcnt(0)" ::: "memory")
__device__ __forceinline__ unsigned long long rt() { return __builtin_amdgcn_s_memrealtime(); }
__device__ __forceinline__ unsigned f2bf(float f) { unsigned u = __builtin_bit_cast(unsigned, f); return (u + 0x7fffu + ((u >> 16) & 1u)) >> 16; }
__device__ __forceinline__ unsigned pk2(float lo, float hi) { return f2bf(lo) | (f2bf(hi) << 16); }

#define XB_TMO      128
#define XB_XCNT(j)  (256  + 64 * (j))
#define XB_XSUB(j)  (1280 + 64 * (j))
#define XB_XGEN(j)  (2304 + 64 * (j))
#define XB_TOP      3328
#define XB_TOPGEN   3392
#define XCD_BAR_WORDS 3456
#define XB_SPIN_CAP (1u << 18)

__device__ __forceinline__ unsigned xb_ld(unsigned* p)              { return __hip_atomic_load(p, __ATOMIC_RELAXED, __HIP_MEMORY_SCOPE_AGENT); }
__device__ __forceinline__ unsigned xb_add(unsigned* p, unsigned v) { return __hip_atomic_fetch_add(p, v, __ATOMIC_RELAXED, __HIP_MEMORY_SCOPE_AGENT); }
__device__ __forceinline__ unsigned xb_xcc_id() { return (unsigned)__builtin_amdgcn_s_getreg((3 << 11) | 20) & 0xFu; }
#define XB_SPIN(cond, bar) do { unsigned _sp = 0; while (cond) { __builtin_amdgcn_s_sleep(1); \
    if ((++_sp & 255u) == 0u) { if (xb_ld(&(bar)[XB_TMO])) break; if (_sp > XB_SPIN_CAP) { atomicAdd(&(bar)[XB_TMO], 1u); break; } } } } while (0)

struct XcdBarrier {
    unsigned* bar; unsigned x;
    volatile LAS unsigned* st;
};

__device__ __forceinline__ XcdBarrier xcd_barrier_post(unsigned* bar, volatile LAS unsigned* st) {
    XcdBarrier b; b.bar = bar; b.x = xb_xcc_id(); b.st = st;
    if (threadIdx.x == 0) (void)xb_add(&bar[XB_XCNT(b.x)], 1u);
    return b;
}
__device__ __forceinline__ void xcd_barrier_complete(unsigned* bar, unsigned x, unsigned& nloc, unsigned& nx) {
    const unsigned G = gridDim.x * gridDim.y * gridDim.z;
    unsigned sum, cnt, mine, sp = 0u;
    for (;;) {
        sum = 0u; cnt = 0u; mine = 0u;
#pragma unroll
        for (unsigned j = 0; j < 16; ++j) { const unsigned c = xb_ld(&bar[XB_XCNT(j)]); sum += c; cnt += (c > 0u) ? 1u : 0u; mine = (j == x) ? c : mine; }
        if (sum == G) break;
        __builtin_amdgcn_s_sleep(1);
        if ((++sp & 255u) == 0u) { if (xb_ld(&bar[XB_TMO])) break; if (sp > XB_SPIN_CAP) { atomicAdd(&bar[XB_TMO], 1u); break; } }
    }
    nloc = mine > 0u ? mine : 1u; nx = cnt > 0u ? cnt : 1u;
}

__device__ __forceinline__ void xcd_barrier(const XcdBarrier& b) {
    asm volatile("s_waitcnt vmcnt(0)" ::: "memory");
    __syncthreads();
    if (threadIdx.x == 0) {
        unsigned* bar = b.bar;
        __builtin_amdgcn_s_waitcnt(0);
        unsigned nloc = b.st[0], nx = b.st[1];
        if (nloc == 0u) { xcd_barrier_complete(bar, b.x, nloc, nx); b.st[0] = nloc; b.st[1] = nx; }
        const unsigned old = xb_add(&bar[XB_XSUB(b.x)], 1u);
        const unsigned gen = old / nloc;
        if (old + 1u == (gen + 1u) * nloc) {
            __builtin_amdgcn_fence(__ATOMIC_RELEASE, "agent");
            asm volatile("s_waitcnt vmcnt(0)" ::: "memory");
            const unsigned og = xb_add(&bar[XB_TOP], 1u);
            const unsigned tg = og / nx;
            if (og + 1u == (tg + 1u) * nx) xb_add(&bar[XB_TOPGEN], 1u);
            else XB_SPIN(xb_ld(&bar[XB_TOPGEN]) == tg, bar);
            __builtin_amdgcn_fence(__ATOMIC_ACQUIRE, "agent");
            xb_add(&bar[XB_XGEN(b.x)], 1u);
            asm volatile("s_waitcnt vmcnt(0)" ::: "memory");
        } else {
            XB_SPIN(xb_ld(&bar[XB_XGEN(b.x)]) == gen, bar);
            __builtin_amdgcn_fence(__ATOMIC_ACQUIRE, "agent");
            asm volatile("s_waitcnt vmcnt(0)" ::: "memory");
        }
    }
    __syncthreads();
}
constexpr int NWAVES = 8;
constexpr int N_LAUNCHES = MK_N_LAUNCHES;
constexpr int N_PHASES = 10;
constexpr int BATCH = 16, SEQ = 2048, DM = 1024, T = BATCH * SEQ;
constexpr int IN_COLS = 3072, NEXP = 16384;
constexpr float EPS = 1e-6f;
constexpr size_t MiB = 1u << 20;
constexpr size_t WS_CTL = 0, CTL_ZERO_BYTES = 1 * MiB;
constexpr size_t WS_MODP = 1 * MiB;
constexpr size_t WS_MOD = 4 * MiB;
constexpr size_t WS_SS = 5 * MiB;
constexpr size_t WS_WIN = 8 * MiB, WS_WO = 14 * MiB, WS_WK = 16 * MiB;
constexpr size_t WS_U = 32 * MiB, WS_V = 64 * MiB;
constexpr size_t WS_H = 96 * MiB;
constexpr size_t WS_TOPK = 160 * MiB;
constexpr size_t WS_IDX = 192 * MiB, WS_GW = 208 * MiB;
constexpr size_t WS_Q = 224 * MiB, WS_K = 256 * MiB, WS_VV = 288 * MiB, WS_CB = 320 * MiB, WS_GC = 352 * MiB;
constexpr size_t WS_MIX = 384 * MiB;
constexpr size_t WS_SC = 224 * MiB;
constexpr size_t WS_END = 480 * MiB;
constexpr int CW_BAR = 4096;
constexpr int RING_BYTES = 131072, LDSCTL_OFF = RING_BYTES, MISC_OFF = LDSCTL_OFF + 320, LDS_BYTES = 147456;

typedef __bf16 bf16x2_t __attribute__((ext_vector_type(2)));
__device__ __forceinline__ float bflo(unsigned w) { return __uint_as_float(w << 16); }
__device__ __forceinline__ float bfhi(unsigned w) { return __uint_as_float(w & 0xffff0000u); }
__device__ __forceinline__ float dot2bf(unsigned a, unsigned b, float acc) { return __builtin_amdgcn_fdot2_f32_bf16(__builtin_bit_cast(bf16x2_t, a), __builtin_bit_cast(bf16x2_t, b), acc, false); }
__device__ __forceinline__ float wave_sum(float v) {
#pragma unroll
    for (int o = 1; o < 64; o <<= 1) v += __shfl_xor(v, o);
    return v;
}
struct Args { const float* in[20]; float* out; unsigned char* ws; int ph_lo, ph_hi, li, pad; };
struct Frame {
    LAS unsigned char* lds; unsigned char* ldsg;
    int tid, lane, wave, vcu, G, gw, NGW;
};

__device__ __forceinline__ void transpose_item(const float* W, int K, int N, bf16* WT, int k0, int n0, int out_row0, LAS float* scr, int lane) {
#pragma unroll 8
    for (int i = 0; i < 32; ++i) { const int kk = 2 * i + (lane >> 5); scr[kk * 33 + (lane & 31)] = W[(size_t)(k0 + kk) * N + n0 + (lane & 31)]; }
    LDS_WAIT(); asm volatile("" ::: "memory");
    const int c = lane & 7;
#pragma unroll
    for (int j = 0; j < 4; ++j) { const int n = (lane >> 3) + 8 * j; const LAS float* s = scr + (8 * c) * 33 + n;
        v4u o; o.x = pk2(s[0 * 33], s[1 * 33]); o.y = pk2(s[2 * 33], s[3 * 33]); o.z = pk2(s[4 * 33], s[5 * 33]); o.w = pk2(s[6 * 33], s[7 * 33]);
        *(GAS v4u*)(WT + (size_t)(out_row0 + n) * K + k0 + 8 * c) = o; }
    LDS_WAIT(); asm volatile("" ::: "memory");
}
__device__ __forceinline__ int win_row(int n) {
    if (n < 2048) return n;
    if (n < 2560) { const int j = n - 2048; return (8 + (j >> 7)) * 256 + (j & 127); }
    const int j = n - 2560; return (8 + (j >> 7)) * 256 + 128 + (j & 127);
}
__device__ __forceinline__ void phase0(const Frame& F, const Args& a) {
    const float* c = a.in[1]; const float* ada_w = a.in[2];
    const float* w_in = a.in[5]; const float* w_o = a.in[13]; const float* wq = a.in[15]; const float* keys = a.in[16];
    unsigned char* ws = a.ws;
    {
        LAS float* kL = (LAS float*)F.lds;
        LAS float* wL = (LAS float*)(F.lds + 128 * 129 * 4);
        bf16* WK = (bf16*)(ws + WS_WK);
        for (int it = F.vcu; it < 256; it += F.G) {
            const int hp = it >> 4, kb = it & 15;
            for (int i = F.tid; i < 128 * 128; i += 512) { const int n = i >> 7, d = i & 127; kL[n * 129 + d] = keys[(size_t)hp * 16384 + i]; }
            for (int i = F.tid; i < 64 * 128; i += 512) { const int k = i >> 7, d = i & 127; wL[k * 129 + d] = wq[(size_t)(kb * 64 + k) * 2048 + hp * 128 + d]; }
            __syncthreads();
            const int n = F.tid & 127, kq = F.tid >> 7;
            float acc[16];
#pragma unroll
            for (int i = 0; i < 16; ++i) acc[i] = 0.f;
            for (int d = 0; d < 128; ++d) { const float kv = kL[n * 129 + d];
#pragma unroll
                for (int i = 0; i < 16; ++i) acc[i] = fmaf(kv, wL[(kq * 16 + i) * 129 + d], acc[i]); }
            bf16* op = WK + (size_t)(hp * 128 + n) * 1024 + kb * 64 + kq * 16;
            v4u o0, o1; o0.x = pk2(acc[0], acc[1]); o0.y = pk2(acc[2], acc[3]); o0.z = pk2(acc[4], acc[5]); o0.w = pk2(acc[6], acc[7]);
            o1.x = pk2(acc[8], acc[9]); o1.y = pk2(acc[10], acc[11]); o1.z = pk2(acc[12], acc[13]); o1.w = pk2(acc[14], acc[15]);
            *(GAS v4u*)op = o0; *(GAS v4u*)(op + 8) = o1;
            __syncthreads();
        }
    }
    LAS float* scr = (LAS float*)(F.lds + F.wave * 16384);
    {
        float* MODP = (float*)(ws + WS_MODP);
        for (int it = F.gw; it < 768; it += F.NGW) {
            const int kc = it / 96, cc = it % 96, col = cc * 64 + F.lane;
#pragma unroll 4
            for (int i = 0; i < 32; ++i) { const int b = i >> 1, kk = (i & 1) * 64 + F.lane; const float cv = c[b * 1024 + kc * 128 + kk]; scr[b * 128 + kk] = cv / (1.f + expf(-cv)); }
            LDS_WAIT(); asm volatile("" ::: "memory");
            float acc[16];
#pragma unroll
            for (int b = 0; b < 16; ++b) acc[b] = 0.f;
#pragma unroll 4
            for (int k = 0; k < 128; ++k) { const float w = ada_w[(size_t)(kc * 128 + k) * 6144 + col];
#pragma unroll
                for (int b = 0; b < 16; ++b) acc[b] = fmaf(scr[b * 128 + k], w, acc[b]); }
#pragma unroll
            for (int b = 0; b < 16; ++b) MODP[(size_t)(kc * 16 + b) * 6144 + col] = acc[b];
            LDS_WAIT(); asm volatile("" ::: "memory");
        }
    }
    {
        bf16* WIN = (bf16*)(ws + WS_WIN); bf16* WO = (bf16*)(ws + WS_WO);
        constexpr int I_IN = 16 * 96, I_O = 16 * 32;
        for (int it = F.gw; it < I_IN + I_O; it += F.NGW) {
            if (it < I_IN) { const int kb = it / 96, nb = it % 96; transpose_item(w_in, 1024, 3072, WIN, kb * 64, nb * 32, win_row(nb * 32), scr, F.lane); }
            else { const int r = it - I_IN, kb = r / 32, nb = r % 32; transpose_item(w_o, 1024, 1024, WO, kb * 64, nb * 32, nb * 32, scr, F.lane); }
        }
    }
    {
        const float* pu = a.in[17]; const float* pv = a.in[18]; bf16* U = (bf16*)(ws + WS_U); bf16* V = (bf16*)(ws + WS_V);
        const size_t n8 = (size_t)NEXP * 1024 / 8; const size_t nthr = (size_t)F.G * 512;
        for (size_t i = (size_t)F.vcu * 512 + F.tid; i < 2 * n8; i += nthr) {
            const bool isu = i < n8; const size_t j = isu ? i : i - n8; const float* s = (isu ? pu : pv) + j * 8;
            const f32x4 x0 = *(const GAS f32x4*)s, x1 = *(const GAS f32x4*)(s + 4);
            v4u o; o.x = pk2(x0[0], x0[1]); o.y = pk2(x0[2], x0[3]); o.z = pk2(x1[0], x1[1]); o.w = pk2(x1[2], x1[3]);
            *(GAS v4u*)((isu ? U : V) + j * 8) = o;
        }
    }
}

template <bool FROM_PARTIALS, bool USE_SS>
__device__ __forceinline__ void norm_rows(const Frame& F, const float* __restrict__ src, bf16* __restrict__ dst, const float* __restrict__ gvec, const float* __restrict__ modsrc  ,
                                          const float* __restrict__ ada_b, int sh_off, int sc_off, const float* __restrict__ SS) {
    LAS float* sS = (LAS float*)F.lds; LAS float* sH = sS + 1024;
    for (int rb = F.vcu; rb < T / 128; rb += F.G) {
        const int b = rb >> 4;
        for (int k = F.tid; k < 1024; k += 512) {
            float sc, sh;
            if (FROM_PARTIALS) { sc = ada_b[sc_off + k]; sh = ada_b[sh_off + k];
#pragma unroll
                for (int kc = 0; kc < 8; ++kc) { sc += modsrc[(size_t)(kc * 16 + b) * 6144 + sc_off + k]; sh += modsrc[(size_t)(kc * 16 + b) * 6144 + sh_off + k]; } }
            else { sc = modsrc[(size_t)b * 6144 + sc_off + k]; sh = modsrc[(size_t)b * 6144 + sh_off + k]; }
            sS[k] = gvec[k] * (1.f + sc); sH[k] = sh;
        }
        __syncthreads();
        for (int i = 0; i < 16; ++i) {
            const int row = rb * 128 + F.wave * 16 + i;
            const GAS f32x4* xr = (const GAS f32x4*)(src + (size_t)row * 1024) + F.lane;
            f32x4 v[4]; float s = 0.f;
#pragma unroll
            for (int j = 0; j < 4; ++j) { v[j] = xr[64 * j]; s += (v[j].x * v[j].x + v[j].y * v[j].y) + (v[j].z * v[j].z + v[j].w * v[j].w); }
            float tot;
            if (USE_SS) { const f32x4* sp = (const f32x4*)(SS + (size_t)row * 16); const f32x4 a0 = sp[0], a1 = sp[1], a2 = sp[2], a3 = sp[3];
                tot = (((a0.x + a0.y) + (a0.z + a0.w)) + ((a1.x + a1.y) + (a1.z + a1.w))) + (((a2.x + a2.y) + (a2.z + a2.w)) + ((a3.x + a3.y) + (a3.z + a3.w))); }
            else tot = wave_sum(s);
            const float r = 1.f / sqrtf(tot * (1.f / 1024.f) + EPS);
            GAS unsigned long long* o8 = (GAS unsigned long long*)(dst + (size_t)row * 1024) + F.lane;
#pragma unroll
            for (int j = 0; j < 4; ++j) { const int k = 4 * F.lane + 256 * j; const f32x4 sc = *(const LAS f32x4*)(sS + k), sh = *(const LAS f32x4*)(sH + k);
                const f32x4 y = v[j] * r * sc + sh;
                o8[64 * j] = (unsigned long long)pk2(y.x, y.y) | ((unsigned long long)pk2(y.z, y.w) << 32); }
        }
        __syncthreads();
    }
}
__device__ __forceinline__ void phase1(const Frame& F, const Args& a) {
    unsigned char* ws = a.ws;
    norm_rows<true, false>(F, a.in[0], (bf16*)(ws + WS_H), a.in[4], (const float*)(ws + WS_MODP), a.in[3], 0, 1024, nullptr);
    const float* MODP = (const float*)(ws + WS_MODP); float* MOD = (float*)(ws + WS_MOD);
    for (int i = F.vcu * 512 + F.tid; i < 16 * 6144; i += F.G * 512) { float s = a.in[3][i % 6144];
#pragma unroll
        for (int kc = 0; kc < 8; ++kc) s += MODP[(size_t)kc * 98304 + i];
        MOD[i] = s; }
}

__device__ __forceinline__ void phase3(const Frame& F, const Args& a) {
    unsigned char* ws = a.ws;
    const bf16* Q = (const bf16*)(ws + WS_Q); const bf16* K = (const bf16*)(ws + WS_K); const bf16* V = (const bf16*)(ws + WS_VV);
    bf16* MIX = (bf16*)(ws + WS_MIX);
    float lam;
    { float p = a.in[7][F.lane] * a.in[8][F.lane], q = a.in[9][F.lane] * a.in[10][F.lane]; p = wave_sum(p); q = wave_sum(q); lam = expf(p) - expf(q) + 0.2f; }
    for (int v = F.vcu; v < 256; v += F.G) {
        const int bh = v >> 2, s = v & 3, b = bh >> 2, h = bh & 3;
        const float sl2 = exp2f(-2.f * (float)(h + 1)) * 1.4426950408889634f;
        for (int i = 0; i < 4; ++i) { const int u = (i == 0) ? 15 - s : (i == 1) ? 8 + s : (i == 2) ? 7 - s : s;
            att::attn_unit(b, h, u, Q, K, V, MIX, a.in[11] + h * 128, lam, sl2, (char*)F.ldsg); }
    }
    const bf16* CB = (const bf16*)(ws + WS_CB); const bf16* GC = (const bf16*)(ws + WS_GC);
    const float* cw = a.in[6]; const float* cg = a.in[12];
    const int c0 = 8 * F.lane;
    float w0[8], w1[8], w2[8], gn[8];
#pragma unroll
    for (int k = 0; k < 8; ++k) { w0[k] = cw[c0 + k]; w1[k] = cw[512 + c0 + k]; w2[k] = cw[1024 + c0 + k]; gn[k] = cg[c0 + k]; }
    for (int tg = F.gw; tg < T / 16; tg += F.NGW) {
        const int t0 = tg * 16; const bool first = (t0 % SEQ) == 0;
        float g2[8], g1[8];
        if (first) {
#pragma unroll
            for (int k = 0; k < 8; ++k) { g2[k] = 0.f; g1[k] = 0.f; } }
        else { const v4u a2 = *(const GAS v4u*)(GC + (size_t)(t0 - 2) * 512 + c0), a1 = *(const GAS v4u*)(GC + (size_t)(t0 - 1) * 512 + c0);
            g2[0] = bflo(a2.x); g2[1] = bfhi(a2.x); g2[2] = bflo(a2.y); g2[3] = bfhi(a2.y); g2[4] = bflo(a2.z); g2[5] = bfhi(a2.z); g2[6] = bflo(a2.w); g2[7] = bfhi(a2.w);
            g1[0] = bflo(a1.x); g1[1] = bfhi(a1.x); g1[2] = bflo(a1.y); g1[3] = bfhi(a1.y); g1[4] = bflo(a1.z); g1[5] = bfhi(a1.z); g1[6] = bflo(a1.w); g1[7] = bfhi(a1.w); }
        for (int i = 0; i < 16; ++i) { const int t = t0 + i;
            const v4u ag = *(const GAS v4u*)(GC + (size_t)t * 512 + c0), ab = *(const GAS v4u*)(CB + (size_t)t * 512 + c0);
            float g0[8], cb[8], cv[8];
            g0[0] = bflo(ag.x); g0[1] = bfhi(ag.x); g0[2] = bflo(ag.y); g0[3] = bfhi(ag.y); g0[4] = bflo(ag.z); g0[5] = bfhi(ag.z); g0[6] = bflo(ag.w); g0[7] = bfhi(ag.w);
            cb[0] = bflo(ab.x); cb[1] = bfhi(ab.x); cb[2] = bflo(ab.y); cb[3] = bfhi(ab.y); cb[4] = bflo(ab.z); cb[5] = bfhi(ab.z); cb[6] = bflo(ab.w); cb[7] = bfhi(ab.w);
            float s = 0.f;
#pragma unroll
            for (int k = 0; k < 8; ++k) { cv[k] = cb[k] * (w0[k] * g2[k] + w1[k] * g1[k] + w2[k] * g0[k]); s += cv[k] * cv[k]; g2[k] = g1[k]; g1[k] = g0[k]; }
            s = wave_sum(s);
            const float r = 1.f / sqrtf(s * (1.f / 512.f) + EPS);
            v4u o; o.x = pk2(cv[0] * r * gn[0], cv[1] * r * gn[1]); o.y = pk2(cv[2] * r * gn[2], cv[3] * r * gn[3]); o.z = pk2(cv[4] * r * gn[4], cv[5] * r * gn[5]); o.w = pk2(cv[6] * r * gn[6], cv[7] * r * gn[7]);
            *(GAS v4u*)(MIX + (size_t)t * 1024 + 512 + c0) = o; }
    }
}

__device__ __forceinline__ unsigned ordkey(float f) { const unsigned u = __float_as_uint(f); return u ^ ((unsigned)((int)u >> 31) | 0x80000000u); }
__device__ __forceinline__ float unordkey(unsigned k) { const unsigned u = (k & 0x80000000u) ? (k ^ 0x80000000u) : ~k; return __uint_as_float(u); }
__device__ __forceinline__ void phase7(const Frame& F, const Args& a) {
    const float* SC = (const float*)(a.ws + WS_SC); unsigned* TOPK = (unsigned*)(a.ws + WS_TOPK);
    LAS float* scr = (LAS float*)(F.lds + F.wave * 16384);
    for (int wv = F.gw; wv < T * 16 / 64; wv += F.NGW) {
        const size_t vb = (size_t)wv * 64;
        unsigned L[16];
#pragma unroll
        for (int j = 0; j < 16; ++j) L[j] = 0u;
        for (int cch = 0; cch < 4; ++cch) {
#pragma unroll 8
            for (int i = 0; i < 32; ++i) { const int row = 2 * i + (F.lane >> 5); scr[row * 33 + (F.lane & 31)] = SC[(vb + row) * 128 + cch * 32 + (F.lane & 31)]; }
            LDS_WAIT(); asm volatile("" ::: "memory");
#pragma unroll 4
            for (int cc = 0; cc < 32; ++cc) {
                unsigned key = (ordkey(scr[F.lane * 33 + cc]) & 0xFFFFFF80u) | (unsigned)(127 - (cch * 32 + cc));
#pragma unroll
                for (int j = 0; j < 16; ++j) { const unsigned hi = L[j] > key ? L[j] : key, lo = L[j] > key ? key : L[j]; L[j] = hi; key = lo; }
            }
            LDS_WAIT(); asm volatile("" ::: "memory");
        }
        GAS v4u* op = (GAS v4u*)(TOPK + (vb + F.lane) * 16);
        op[0] = (v4u){L[0], L[1], L[2], L[3]}; op[1] = (v4u){L[4], L[5], L[6], L[7]}; op[2] = (v4u){L[8], L[9], L[10], L[11]}; op[3] = (v4u){L[12], L[13], L[14], L[15]};
    }
}
__device__ __forceinline__ void phase8(const Frame& F, const Args& a) {
    const unsigned* TOPK = (const unsigned*)(a.ws + WS_TOPK); int* IDX = (int*)(a.ws + WS_IDX); float* GWT = (float*)(a.ws + WS_GW);
    LAS unsigned* my = (LAS unsigned*)F.lds + F.tid * 33;
    for (int id = F.vcu * 512 + F.tid; id < T * 8; id += F.G * 512) {
        const GAS v4u* ip = (const GAS v4u*)(TOPK + (size_t)id * 32);
        unsigned k0[16], k1[16];
#pragma unroll
        for (int q = 0; q < 4; ++q) { const v4u x = ip[q], y = ip[4 + q]; k0[4 * q] = x.x; k0[4 * q + 1] = x.y; k0[4 * q + 2] = x.z; k0[4 * q + 3] = x.w; k1[4 * q] = y.x; k1[4 * q + 1] = y.y; k1[4 * q + 2] = y.z; k1[4 * q + 3] = y.w; }
        float s0[16], s1[16];
#pragma unroll
        for (int i = 0; i < 16; ++i) { s0[i] = unordkey(k0[i] & 0xFFFFFF80u); s1[i] = unordkey(k1[i] & 0xFFFFFF80u); my[i] = k0[i]; my[16 + i] = k1[i]; }
        unsigned M[16];
#pragma unroll
        for (int j = 0; j < 16; ++j) M[j] = 0u;
#pragma unroll
        for (int i = 0; i < 16; ++i)
#pragma unroll
            for (int j = 0; j < 16; ++j) if ((i + 1) * (j + 1) <= 16) {
                unsigned key = (ordkey(s0[i] + s1[j]) & 0xFFFFFF00u) | (unsigned)(255 - (i * 16 + j));
#pragma unroll
                for (int q = 0; q < 16; ++q) { const unsigned hi = M[q] > key ? M[q] : key, lo = M[q] > key ? key : M[q]; M[q] = hi; key = lo; }
            }
        LDS_WAIT(); asm volatile("" ::: "memory");
        float bv[16]; int ev[16]; float mx = -3.0e38f;
#pragma unroll
        for (int q = 0; q < 16; ++q) { const unsigned ij = 255u - (M[q] & 255u); const unsigned ka = my[ij >> 4], kb = my[16 + (ij & 15u)];
            bv[q] = unordkey(ka & 0xFFFFFF80u) + unordkey(kb & 0xFFFFFF80u); ev[q] = (int)((127u - (ka & 127u)) * 128u + (127u - (kb & 127u))); mx = fmaxf(mx, bv[q]); }
        float sum = 0.f;
#pragma unroll
        for (int q = 0; q < 16; ++q) { bv[q] = expf(bv[q] - mx); sum += bv[q]; }
        const float inv = 1.f / sum;
        GAS v4u* oi = (GAS v4u*)(IDX + (size_t)id * 16); GAS f32x4* og = (GAS f32x4*)(GWT + (size_t)id * 16);
#pragma unroll
        for (int q = 0; q < 4; ++q) { oi[q] = (v4u){(unsigned)ev[4 * q], (unsigned)ev[4 * q + 1], (unsigned)ev[4 * q + 2], (unsigned)ev[4 * q + 3]};
            og[q] = (f32x4){bv[4 * q] * inv, bv[4 * q + 1] * inv, bv[4 * q + 2] * inv, bv[4 * q + 3] * inv}; }
        LDS_WAIT(); asm volatile("" ::: "memory");
    }
}

__device__ __forceinline__ float gelu_erf(float v) { return 0.5f * v * (1.f + erff(v * 0.70710678118654752f)); }
__device__ __forceinline__ float dot8(const v4u& w, const v4u& x, float acc) { acc = dot2bf(w.x, x.x, acc); acc = dot2bf(w.y, x.y, acc); acc = dot2bf(w.z, x.z, acc); return dot2bf(w.w, x.w, acc); }
__device__ __forceinline__ void phase9(const Frame& F, const Args& a) {
    unsigned char* ws = a.ws;
    const bf16* H = (const bf16*)(ws + WS_H); const bf16* U = (const bf16*)(ws + WS_U); const bf16* V = (const bf16*)(ws + WS_V);
    const int* IDX = (const int*)(ws + WS_IDX); const float* GWT = (const float*)(ws + WS_GW); const float* MOD = (const float*)(ws + WS_MOD);
    float* X = a.out; const float* fg = a.in[19];
    const int lane = F.lane, hi5 = lane >> 5, b4 = (lane >> 4) & 1, b3 = (lane >> 3) & 1;
    for (int t = F.gw; t < T; t += F.NGW) {
        int idv[2]; float gv[2], av[2];
        idv[0] = IDX[(size_t)t * 128 + lane]; idv[1] = IDX[(size_t)t * 128 + 64 + lane];
        gv[0] = GWT[(size_t)t * 128 + lane]; gv[1] = GWT[(size_t)t * 128 + 64 + lane];
        const v4u ha = *(const GAS v4u*)(H + (size_t)t * 1024 + 8 * lane), hb = *(const GAS v4u*)(H + (size_t)t * 1024 + 512 + 8 * lane);
        av[0] = 0.f; av[1] = 0.f;
#pragma unroll
        for (int half = 0; half < 2; ++half) {
            for (int e0 = 0; e0 < 64; e0 += 8) {
                float d[8];
#pragma unroll
                for (int k = 0; k < 8; ++k) { const int row = __builtin_amdgcn_readlane(idv[half], e0 + k); const bf16* up = U + (size_t)row * 1024 + 8 * lane;
                    const v4u ua = *(const GAS v4u*)up, ub = *(const GAS v4u*)(up + 512); d[k] = dot8(ub, hb, dot8(ua, ha, 0.f)); }
                float r4[4], r2[2];
#pragma unroll
                for (int k = 0; k < 4; ++k) { const float mine = hi5 ? d[k + 4] : d[k], theirs = hi5 ? d[k] : d[k + 4]; r4[k] = mine + __shfl_xor(theirs, 32); }
#pragma unroll
                for (int k = 0; k < 2; ++k) { const float mine = b4 ? r4[k + 2] : r4[k], theirs = b4 ? r4[k] : r4[k + 2]; r2[k] = mine + __shfl_xor(theirs, 16); }
                float vsum; { const float mine = b3 ? r2[1] : r2[0], theirs = b3 ? r2[0] : r2[1]; vsum = mine + __shfl_xor(theirs, 8); }
                vsum += __shfl_xor(vsum, 4); vsum += __shfl_xor(vsum, 2); vsum += __shfl_xor(vsum, 1);
                const float got = __shfl(vsum, ((lane - e0) & 7) * 8);
                if (lane >= e0 && lane < e0 + 8) av[half] = got;
            }
        }
        float wv[2];
        wv[0] = gv[0] * gelu_erf(av[0]); wv[1] = gv[1] * gelu_erf(av[1]);
        float acc[16];
#pragma unroll
        for (int i = 0; i < 16; ++i) acc[i] = 0.f;
#pragma unroll
        for (int half = 0; half < 2; ++half) {
            for (int e0 = 0; e0 < 64; e0 += 8) {
                v4u va[8], vb[8]; float wk[8];
#pragma unroll
                for (int k = 0; k < 8; ++k) { const int row = __builtin_amdgcn_readlane(idv[half], e0 + k); const bf16* vp = V + (size_t)row * 1024 + 8 * lane;
                    va[k] = *(const GAS v4u*)vp; vb[k] = *(const GAS v4u*)(vp + 512); wk[k] = __uint_as_float(__builtin_amdgcn_readlane(__float_as_uint(wv[half]), e0 + k)); }
#pragma unroll
                for (int k = 0; k < 8; ++k) {
                    acc[0] = fmaf(wk[k], bflo(va[k].x), acc[0]); acc[1] = fmaf(wk[k], bfhi(va[k].x), acc[1]); acc[2] = fmaf(wk[k], bflo(va[k].y), acc[2]); acc[3] = fmaf(wk[k], bfhi(va[k].y), acc[3]);
                    acc[4] = fmaf(wk[k], bflo(va[k].z), acc[4]); acc[5] = fmaf(wk[k], bfhi(va[k].z), acc[5]); acc[6] = fmaf(wk[k], bflo(va[k].w), acc[6]); acc[7] = fmaf(wk[k], bfhi(va[k].w), acc[7]);
                    acc[8] = fmaf(wk[k], bflo(vb[k].x), acc[8]); acc[9] = fmaf(wk[k], bfhi(vb[k].x), acc[9]); acc[10] = fmaf(wk[k], bflo(vb[k].y), acc[10]); acc[11] = fmaf(wk[k], bfhi(vb[k].y), acc[11]);
                    acc[12] = fmaf(wk[k], bflo(vb[k].z), acc[12]); acc[13] = fmaf(wk[k], bfhi(vb[k].z), acc[13]); acc[14] = fmaf(wk[k], bflo(vb[k].w), acc[14]); acc[15] = fmaf(wk[k], bfhi(vb[k].w), acc[15]); }
            }
        }
        const int b = t >> 11; const float* g2p = MOD + (size_t)b * 6144 + 5120;
        float* xr = X + (size_t)t * 1024; float x2[16]; float ss = 0.f;
#pragma unroll
        for (int q = 0; q < 4; ++q) { const int col = (q >> 1) * 512 + 8 * lane + (q & 1) * 4; const f32x4 xv = *(const GAS f32x4*)(xr + col), gg = *(const f32x4*)(g2p + col);
#pragma unroll
            for (int i = 0; i < 4; ++i) { const float y = xv[i] + gg[i] * acc[q * 4 + i]; x2[q * 4 + i] = y; ss += y * y; } }
        ss = wave_sum(ss);
        const float r = 1.f / sqrtf(ss * (1.f / 1024.f) + EPS);
#pragma unroll
        for (int q = 0; q < 4; ++q) { const int col = (q >> 1) * 512 + 8 * lane + (q & 1) * 4; const f32x4 fgv = *(const f32x4*)(fg + col);
            *(GAS f32x4*)(xr + col) = (f32x4){x2[q * 4] * r * fgv[0], x2[q * 4 + 1] * r * fgv[1], x2[q * 4 + 2] * r * fgv[2], x2[q * 4 + 3] * r * fgv[3]}; }
    }
}
__global__ void __launch_bounds__(NWAVES * 64, 2) mk_fwd(Args args) {
    extern __shared__ __attribute__((aligned(16))) unsigned char lds[];
    Frame F;
    F.lds = (LAS unsigned char*)lds; F.ldsg = lds;
    F.tid = threadIdx.x; F.lane = F.tid & 63; F.wave = __builtin_amdgcn_readfirstlane(F.tid >> 6);
    F.G = gridDim.x; { const int bx = blockIdx.x; F.vcu = (F.G % 8 == 0) ? (bx % 8) * (F.G / 8) + bx / 8 : bx; }
    F.gw = F.vcu * NWAVES + F.wave; F.NGW = F.G * NWAVES;
    volatile LAS unsigned* MISC = (volatile LAS unsigned*)(F.lds + MISC_OFF);
    unsigned char* ws = args.ws;
    gu32* ctl = (gu32*)(ws + WS_CTL);
    for (int u = F.tid; u < (LDS_BYTES - LDSCTL_OFF) / 4; u += NWAVES * 64) ((LAS unsigned*)(F.lds + LDSCTL_OFF))[u] = 0u;
    __syncthreads();
    const int lo = args.ph_lo, hi = args.ph_hi;
    XcdBarrier bar; bar.bar = (unsigned*)(ctl + CW_BAR) + args.li * XCD_BAR_WORDS; bar.x = 0; bar.st = nullptr;
    if (hi - lo > 1) bar = xcd_barrier_post((unsigned*)(ctl + CW_BAR) + args.li * XCD_BAR_WORDS, MISC + 8);
#ifndef PHASE_MASK
#define PHASE_MASK 0x3ff
#endif
#define IN(k) (((PHASE_MASK >> (k)) & 1) && lo <= (k) && (k) < hi)
#define SEAM(k) do { if (IN(k) && IN((k) + 1)) xcd_barrier(bar); } while (0)

    if (IN(0)) { phase0(F, args); } SEAM(0);
    if (IN(1)) { __syncthreads(); phase1(F, args); } SEAM(1);
    if (IN(2)) { __syncthreads();
        pg8::Gemm g{(const pg8::bf16_t*)(ws + WS_H), (const pg8::bf16_t*)(ws + WS_WIN), T, IN_COLS, DM}; pg8::StaticOrder S; S.init(T, IN_COLS, F.G, (int)blockIdx.x);
        pg8::EpiP E{(pg8::bf16_t*)(ws + WS_Q), (pg8::bf16_t*)(ws + WS_K), (pg8::bf16_t*)(ws + WS_VV), (pg8::bf16_t*)(ws + WS_CB), (pg8::bf16_t*)(ws + WS_GC), 0.125f * 1.4426950408889634f};
        pg8::gemm_phase<pg8::EpiP, pg8::StaticOrder, true, true>(F.lds, g, S, E); } SEAM(2);
    if (IN(3)) { __syncthreads(); phase3(F, args); } SEAM(3);
    if (IN(4)) { __syncthreads();
        pg8::Gemm g{(const pg8::bf16_t*)(ws + WS_MIX), (const pg8::bf16_t*)(ws + WS_WO), T, DM, DM}; pg8::StaticOrder S; S.init(T, DM, F.G, (int)blockIdx.x);
        pg8::EpiRes E{args.in[0], args.out, (const float*)(ws + WS_MOD), (float*)(ws + WS_SS)};
        pg8::gemm_phase<pg8::EpiRes, pg8::StaticOrder, true, true>(F.lds, g, S, E); } SEAM(4);
    if (IN(5)) { __syncthreads(); norm_rows<false, true>(F, args.out, (bf16*)(ws + WS_H), args.in[14], (const float*)(ws + WS_MOD), nullptr, 3072, 4096, (const float*)(ws + WS_SS)); } SEAM(5);
    if (IN(6)) { __syncthreads();
        pg8::Gemm g{(const pg8::bf16_t*)(ws + WS_H), (const pg8::bf16_t*)(ws + WS_WK), T, 2048, DM}; pg8::StaticOrder S; S.init(T, 2048, F.G, (int)blockIdx.x);
        pg8::EpiF32 E{(float*)(ws + WS_SC), 2048};
        pg8::gemm_phase<pg8::EpiF32, pg8::StaticOrder, true, true>(F.lds, g, S, E); } SEAM(6);
    if (IN(7)) { __syncthreads(); phase7(F, args); } SEAM(7);
    if (IN(8)) { __syncthreads(); phase8(F, args); } SEAM(8);
    if (IN(9)) { __syncthreads(); phase9(F, args); }
#undef IN
#undef SEAM
}

extern "C" void kernel_launch(void* const* d_in, const int* in_sizes, int n_in, void* d_out, int out_size, void* d_ws, size_t ws_size, hipStream_t stream) {
    static int grid = 0;
    if (grid == 0) {
        if (n_in != 20 || in_sizes[0] != T * DM || out_size != T * DM || ws_size < WS_END) {
            fprintf(stderr, "kernel_launch: built for 20 inputs, x/out of %d floats, >= %zu bytes of workspace; got n_in %d, in0 %d, out %d, ws %zu; nothing launched\n", T * DM, (size_t)WS_END, n_in, n_in > 0 ? in_sizes[0] : -1, out_size, ws_size);
            grid = -1; return; }
        int dev = 0, cus = 0, per_cu = 0;
        if (hipGetDevice(&dev) != hipSuccess || hipDeviceGetAttribute(&cus, hipDeviceAttributeMultiprocessorCount, dev) != hipSuccess) { fprintf(stderr, "kernel_launch: device query failed\n"); grid = -1; return; }
        if (hipFuncSetAttribute((const void*)mk_fwd, hipFuncAttributeMaxDynamicSharedMemorySize, LDS_BYTES) != hipSuccess) { fprintf(stderr, "kernel_launch: hipFuncSetAttribute failed\n"); grid = -1; return; }
        if (hipOccupancyMaxActiveBlocksPerMultiprocessor(&per_cu, (const void*)mk_fwd, NWAVES * 64, LDS_BYTES) != hipSuccess || per_cu < 1) {
            fprintf(stderr, "kernel_launch: occupancy query reports %d workgroups per CU; nothing launched\n", per_cu); (void)hipGetLastError(); grid = -1; return; }
        grid = cus;
    }
    if (grid < 0) return;
    if (hipMemsetAsync((char*)d_ws + WS_CTL, 0, CTL_ZERO_BYTES, stream) != hipSuccess) { fprintf(stderr, "kernel_launch: memset failed\n"); return; }
    Args a{};
    for (int i = 0; i < 20; ++i) a.in[i] = (const float*)d_in[i];
    a.out = (float*)d_out; a.ws = (unsigned char*)d_ws;
    if (N_LAUNCHES == 1) { a.ph_lo = 0; a.ph_hi = N_PHASES; a.li = 0; hipLaunchKernelGGL(mk_fwd, dim3(grid), dim3(NWAVES * 64), LDS_BYTES, stream, a); }
    else { for (int p = 0; p < N_PHASES; ++p) { a.ph_lo = p; a.ph_hi = p + 1; a.li = 0; hipLaunchKernelGGL(mk_fwd, dim3(grid), dim3(NWAVES * 64), LDS_BYTES, stream, a); } }
    const hipError_t le = hipPeekAtLastError();
    if (le != hipSuccess) fprintf(stderr, "kernel_launch: launch failed: %s\n", hipGetErrorName(le));
}
```

```cpp
#include <hip/hip_runtime.h>
#include <hip/hip_bf16.h>
#include <cstdio>
#include <cstdint>
#include <cmath>

#define REP_MASK 0
#define PG8_REPG 1
#define ATT_REP 1
#ifndef MK_N_LAUNCHES
#define MK_N_LAUNCHES 1
#endif

#ifndef PG8_REPG
#define PG8_REPG 1
#endif
namespace pg8 {
#define PG8_LAS __attribute__((address_space(3)))
typedef unsigned short bf16_t;
typedef short bf16x8 __attribute__((ext_vector_type(8)));
typedef float f32x4 __attribute__((ext_vector_type(4)));
typedef unsigned u32x4 __attribute__((ext_vector_type(4)));
constexpr int BM = 256, BK = 64, HALF = 128, HTB = HALF * BK * 2  , STAGE_BYTES = 8 * HTB, NXCD = 8, WGM = 8;

__host__ __device__ __forceinline__ int lds_byte(int r, int c) { const int st = (r >> 4) * 2 + (c >> 5), rr = r & 15, cc = c & 31, ob = rr * 64 + cc * 2; return st * 1024 + (ob ^ (((ob >> 9) & 1) << 5)); }
__host__ __device__ __forceinline__ void stage_rc(int b, int& R, int& C) { const int st = b / 1024, sb = b % 1024, swz = sb ^ (((sb >> 9) & 1) << 5); R = (st >> 1) * 16 + swz / 64; C = (st & 1) * 32 + (swz % 64) / 2; }
__host__ __device__ __forceinline__ int perm32(int rho) { const int n = rho >> 4, i = rho & 15; return 8 * (i >> 2) + 4 * n + (i & 3); }

struct Unit { int pm, pn; };
struct Gemm { const bf16_t* A; const bf16_t* Bt; int M, N, K; };

struct StaticOrder {
    int nM, nN, nwg, G, c, rep;
    __host__ __device__ void init(int M, int N, int G_, int c_, int rep_ = 1) { nM = M / BM; nN = N / BM; nwg = nM * nN; G = G_; c = c_; rep = rep_; }
    __host__ __device__ bool next(int i, Unit& u) const {
        const long L = (long)i * G + c; if (L >= (long)nwg * PG8_REPG * rep) return false;
        int wgid = (int)(L % nwg); { const int q = nwg / NXCD, r = nwg % NXCD, xcd = wgid % NXCD, off = wgid / NXCD; wgid = (xcd < r ? xcd * (q + 1) : r * (q + 1) + (xcd - r) * q) + off; }
        const int nig = WGM * nN, gid = wgid / nig, fm = gid * WGM, gsz = (nM - fm) < WGM ? (nM - fm) : WGM;
        u.pm = fm + ((wgid % nig) % gsz); u.pn = (wgid % nig) / gsz; return true;
    }
    __device__ __forceinline__ void a_ready(const Unit&) const {}
    __device__ __forceinline__ void done(const Unit&) const {}
};

__device__ __forceinline__ unsigned cvt_pk_bf16(float lo, float hi) { unsigned r; asm volatile("v_cvt_pk_bf16_f32 %0, %1, %2" : "=v"(r) : "v"(lo), "v"(hi)); return r; }
__device__ __forceinline__ void st16_wt(const void* base, size_t byte_off, u32x4 w) {
    const __amdgpu_buffer_rsrc_t r = __builtin_amdgcn_make_buffer_rsrc((void*)base, 0, 0x7fffffff, 0x00020000);
    __builtin_amdgcn_raw_buffer_store_b128(w, r, (int)byte_off, 0, 16);
}
struct EpiP {
    static constexpr bool PERM = true, AFTER_DRAIN = false;
    bf16_t *Q, *K, *V, *CB, *GC; float qscale;
    __device__ __forceinline__ static void st16(bf16_t* base, size_t elem_off, u32x4 w) { st16_wt(base, elem_off * 2, w); }
    __device__ __forceinline__ void operator()(const f32x4 (&acc)[2][2][4][2], const Unit& u, int wr, int wc, int fr, int fq) const {
        const int row0 = u.pm * BM + wr * 64 + fr;
        if (u.pn < 8) {
            const int sel = u.pn >> 1; bf16_t* base = sel == 0 ? Q : (sel == 1 ? K : (sel == 2 ? V : CB));
            const float sc = sel == 0 ? qscale : 1.f; const int col0 = (u.pn & 1) * 256 + wc * 32 + 8 * fq;
#pragma unroll
            for (int ai = 0; ai < 2; ++ai)
#pragma unroll
                for (int m = 0; m < 4; ++m) { const size_t off = (size_t)(row0 + ai * HALF + m * 16) * 512 + col0;
#pragma unroll
                    for (int bj = 0; bj < 2; ++bj) { const f32x4 v0 = acc[ai][bj][m][0] * sc, v1 = acc[ai][bj][m][1] * sc;
                        u32x4 w; w.x = cvt_pk_bf16(v0[0], v0[1]); w.y = cvt_pk_bf16(v0[2], v0[3]); w.z = cvt_pk_bf16(v1[0], v1[1]); w.w = cvt_pk_bf16(v1[2], v1[3]);
                        st16(base, off + bj * HALF, w); } }
        } else {
            const int col0 = (u.pn - 8) * 128 + wc * 32 + 8 * fq;
#pragma unroll
            for (int ai = 0; ai < 2; ++ai)
#pragma unroll
                for (int m = 0; m < 4; ++m) { const size_t off = (size_t)(row0 + ai * HALF + m * 16) * 512 + col0;
                    const f32x4 v0 = acc[ai][0][m][0] * acc[ai][1][m][0], v1 = acc[ai][0][m][1] * acc[ai][1][m][1];
                    u32x4 w; w.x = cvt_pk_bf16(v0[0], v0[1]); w.y = cvt_pk_bf16(v0[2], v0[3]); w.z = cvt_pk_bf16(v1[0], v1[1]); w.w = cvt_pk_bf16(v1[2], v1[3]);
                    st16(GC, off, w); }
        }
    }
};
struct EpiGate {
    static constexpr bool PERM = true, AFTER_DRAIN = false;
    bf16_t* O; const float* MOD;
    __device__ __forceinline__ void operator()(const f32x4 (&acc)[2][2][4][2], const Unit& u, int wr, int wc, int fr, int fq) const {
        const int row0 = u.pm * BM + wr * 64 + fr, col0 = u.pn * BM + wc * 32 + 8 * fq; const int b = u.pm >> 3;
        f32x4 gv[2][2];
#pragma unroll
        for (int bj = 0; bj < 2; ++bj)
#pragma unroll
            for (int n = 0; n < 2; ++n) gv[bj][n] = *(const f32x4*)(MOD + (size_t)b * 6144 + 2048 + col0 + bj * HALF + 4 * n);
#pragma unroll
        for (int ai = 0; ai < 2; ++ai)
#pragma unroll
            for (int m = 0; m < 4; ++m) { const size_t off = ((size_t)(row0 + ai * HALF + m * 16) * 1024 + col0) * 2;
#pragma unroll
                for (int bj = 0; bj < 2; ++bj) { const f32x4 v0 = acc[ai][bj][m][0] * gv[bj][0], v1 = acc[ai][bj][m][1] * gv[bj][1];
                    u32x4 w; w.x = cvt_pk_bf16(v0[0], v0[1]); w.y = cvt_pk_bf16(v0[2], v0[3]); w.z = cvt_pk_bf16(v1[0], v1[1]); w.w = cvt_pk_bf16(v1[2], v1[3]);
                    *(u32x4*)((char*)O + off + bj * HALF * 2) = w; } }
    }
};
typedef short s16x2 __attribute__((ext_vector_type(2)));
struct EpiS16 {
    static constexpr bool PERM = true, AFTER_DRAIN = false;
    short* C; int ldc;
    __device__ __forceinline__ static unsigned q2s(float a, float b) { const s16x2 r = __builtin_amdgcn_cvt_pk_i16((int)__builtin_rintf(a), (int)__builtin_rintf(b)); return __builtin_bit_cast(unsigned, r); }
    __device__ __forceinline__ static unsigned q2(float a, float b) { const s16x2 r = __builtin_amdgcn_cvt_pk_i16((int)__builtin_rintf(a * 2048.f), (int)__builtin_rintf(b * 2048.f)); return __builtin_bit_cast(unsigned, r); }
    __device__ __forceinline__ void operator()(const f32x4 (&acc)[2][2][4][2], const Unit& u, int wr, int wc, int fr, int fq) const {
        const int row0 = u.pm * BM + wr * 64 + fr, col0 = u.pn * BM + wc * 32 + 8 * fq;
#pragma unroll
        for (int ai = 0; ai < 2; ++ai)
#pragma unroll
            for (int m = 0; m < 4; ++m) { const size_t off = ((size_t)(row0 + ai * HALF + m * 16) * ldc + col0) * 2;
#pragma unroll
                for (int bj = 0; bj < 2; ++bj) { const f32x4 v0 = acc[ai][bj][m][0], v1 = acc[ai][bj][m][1];
                    u32x4 w; w.x = q2(v0[0], v0[1]); w.y = q2(v0[2], v0[3]); w.z = q2(v1[0], v1[1]); w.w = q2(v1[2], v1[3]);
                    *(u32x4*)((char*)C + off + bj * HALF * 2) = w; } }
    }
};

struct EpiS16I {
    static constexpr bool PERM = true, AFTER_DRAIN = false;
    short* C; int ldc; const float* HS; const float* WKS;
    __device__ __forceinline__ void operator()(const f32x4 (&acc)[2][2][4][2], const Unit& u, int wr, int wc, int fr, int fq) const {
        typedef int i32x4_t __attribute__((ext_vector_type(4)));
        const int row0 = u.pm * BM + wr * 64 + fr, col0 = u.pn * BM + wc * 32 + 8 * fq;
        f32x4 cs[2][2];
#pragma unroll
        for (int bj = 0; bj < 2; ++bj)
#pragma unroll
            for (int n = 0; n < 2; ++n) cs[bj][n] = *(const f32x4*)(WKS + col0 + bj * HALF + 4 * n) * 2048.f;
#pragma unroll
        for (int ai = 0; ai < 2; ++ai)
#pragma unroll
            for (int m = 0; m < 4; ++m) { const int row = row0 + ai * HALF + m * 16; const float rs = HS[row]; short* rowp = C + (size_t)row * ldc + col0;
#pragma unroll
                for (int bj = 0; bj < 2; ++bj) { const i32x4_t a0 = __builtin_bit_cast(i32x4_t, acc[ai][bj][m][0]), a1 = __builtin_bit_cast(i32x4_t, acc[ai][bj][m][1]);
                    const f32x4 v0 = (f32x4){(float)a0[0], (float)a0[1], (float)a0[2], (float)a0[3]} * cs[bj][0] * rs, v1 = (f32x4){(float)a1[0], (float)a1[1], (float)a1[2], (float)a1[3]} * cs[bj][1] * rs;
                    u32x4 w; w.x = EpiS16::q2s(v0[0], v0[1]); w.y = EpiS16::q2s(v0[2], v0[3]); w.z = EpiS16::q2s(v1[0], v1[1]); w.w = EpiS16::q2s(v1[2], v1[3]);
                    *(u32x4*)(rowp + bj * HALF) = w; } }
    }
};
struct EpiPI {
    static constexpr bool PERM = true, AFTER_DRAIN = false;
    bf16_t *Q, *K, *V, *CB, *GC; float qscale; const float* HS; const float* WINS;
    __device__ __forceinline__ static f32x4 cvt4(f32x4 a) { typedef int i32x4_t __attribute__((ext_vector_type(4))); const i32x4_t i = __builtin_bit_cast(i32x4_t, a); return (f32x4){(float)i[0], (float)i[1], (float)i[2], (float)i[3]}; }
    __device__ __forceinline__ void operator()(const f32x4 (&acc)[2][2][4][2], const Unit& u, int wr, int wc, int fr, int fq) const {
        const int row0 = u.pm * BM + wr * 64 + fr; const int ccol0 = u.pn * BM + wc * 32 + 8 * fq;
        f32x4 cs[2][2];
#pragma unroll
        for (int bj = 0; bj < 2; ++bj)
#pragma unroll
            for (int n = 0; n < 2; ++n) cs[bj][n] = *(const f32x4*)(WINS + ccol0 + bj * HALF + 4 * n);
        if (u.pn < 8) {
            const int sel = u.pn >> 1; bf16_t* base = sel == 0 ? Q : (sel == 1 ? K : (sel == 2 ? V : CB));
            const float sc = sel == 0 ? qscale : 1.f; const int col0 = (u.pn & 1) * 256 + wc * 32 + 8 * fq;
#pragma unroll
            for (int ai = 0; ai < 2; ++ai)
#pragma unroll
                for (int m = 0; m < 4; ++m) { const int row = row0 + ai * HALF + m * 16; const float rs = HS[row] * sc; const size_t off = (size_t)row * 512 + col0;
#pragma unroll
                    for (int bj = 0; bj < 2; ++bj) { const f32x4 v0 = cvt4(acc[ai][bj][m][0]) * (cs[bj][0] * rs), v1 = cvt4(acc[ai][bj][m][1]) * (cs[bj][1] * rs);
                        u32x4 w; w.x = cvt_pk_bf16(v0[0], v0[1]); w.y = cvt_pk_bf16(v0[2], v0[3]); w.z = cvt_pk_bf16(v1[0], v1[1]); w.w = cvt_pk_bf16(v1[2], v1[3]);
                        *(u32x4*)(base + off + bj * HALF) = w; } }
        } else {
            const int col0 = (u.pn - 8) * 128 + wc * 32 + 8 * fq;
#pragma unroll
            for (int ai = 0; ai < 2; ++ai)
#pragma unroll
                for (int m = 0; m < 4; ++m) { const int row = row0 + ai * HALF + m * 16; const float rs = HS[row]; const size_t off = (size_t)row * 512 + col0;
                    const f32x4 v0 = (cvt4(acc[ai][0][m][0]) * cs[0][0] * rs) * (cvt4(acc[ai][1][m][0]) * cs[1][0] * rs), v1 = (cvt4(acc[ai][0][m][1]) * cs[0][1] * rs) * (cvt4(acc[ai][1][m][1]) * cs[1][1] * rs);
                    u32x4 w; w.x = cvt_pk_bf16(v0[0], v0[1]); w.y = cvt_pk_bf16(v0[2], v0[3]); w.z = cvt_pk_bf16(v1[0], v1[1]); w.w = cvt_pk_bf16(v1[2], v1[3]);
                    *(u32x4*)(GC + off) = w; }
        }
    }
};
template <bool I8> __device__ __forceinline__ f32x4 mma16(bf16x8 a, bf16x8 b, f32x4 c) {
    if constexpr (I8) { typedef int i32x4_t __attribute__((ext_vector_type(4)));
        return __builtin_bit_cast(f32x4, __builtin_amdgcn_mfma_i32_16x16x64_i8(__builtin_bit_cast(i32x4_t, a), __builtin_bit_cast(i32x4_t, b), __builtin_bit_cast(i32x4_t, c), 0, 0, 0)); }
    else return __builtin_amdgcn_mfma_f32_16x16x32_bf16(a, b, c, 0, 0, 0);
}
template <class Epi, class Sched, bool ALIGN_EPI = false, bool SP2 = false, bool I8 = false>
__device__ __forceinline__ void gemm_phase(PG8_LAS unsigned char* lds, const Gemm g, const Sched& S, const Epi& E) {
    const int tid = threadIdx.x, wid = __builtin_amdgcn_readfirstlane(tid >> 6), lane = tid & 63, wr = wid >> 2, wc = wid & 3, fr = lane & 15, fq = lane >> 4;
    const int K = g.K, nt = K / BK;
    unsigned voffA[2], voffB[2];
#pragma unroll
    for (int i = 0; i < 2; ++i) { int R, C; stage_rc(tid * 16 + i * 8192, R, C); const int Rb = Epi::PERM ? ((R & ~31) + perm32(R & 31)) : R;
        voffA[i] = (unsigned)(R * K + C) * 2u; voffB[i] = (unsigned)(Rb * K + C) * 2u; }
    const size_t kstep = (size_t)(BK * 2);
    const size_t hstep = (size_t)HALF * K * 2;
    const size_t tstep = 2 * hstep;
    const unsigned ldsw = (unsigned)wid * 1024u;
    const int aoff = lds_byte(wr * 64 + fr, fq * 8), boff = lds_byte(wc * 32 + fr, fq * 8);
#define PG8_SA(b, h) (((b) * 2 + (h)) * HTB)
#define PG8_SB(b, h) ((4 + (b) * 2 + (h)) * HTB)
#define PG8_STAGE(bufoff, gbase, voff) do { _Pragma("unroll") for (int _i = 0; _i < 2; ++_i) \
        __builtin_amdgcn_global_load_lds((const unsigned*)((const char*)(gbase) + (voff)[_i]), (PG8_LAS unsigned*)(lds + (bufoff) + ldsw + _i * 8192), 16, 0, 0); } while (0)
#define PG8_LDA(dst, b, h) do { _Pragma("unroll") for (int m = 0; m < 4; ++m) _Pragma("unroll") for (int k = 0; k < 2; ++k) dst[m][k] = *(const PG8_LAS bf16x8*)(lds + PG8_SA(b, h) + aoff + m * 2048 + k * 1024); } while (0)
#define PG8_LDB(dst, b, h) do { _Pragma("unroll") for (int n = 0; n < 2; ++n) _Pragma("unroll") for (int k = 0; k < 2; ++k) dst[n][k] = *(const PG8_LAS bf16x8*)(lds + PG8_SB(b, h) + boff + n * 2048 + k * 1024); } while (0)
#define PG8_MMA(ai, bj, At, Bt) do { __builtin_amdgcn_s_setprio(1); _Pragma("unroll") for (int m = 0; m < 4; ++m) _Pragma("unroll") for (int n = 0; n < 2; ++n) _Pragma("unroll") for (int k = 0; k < 2; ++k) \
        acc[ai][bj][m][n] = mma16<I8>(Bt[n][k], At[m][k], acc[ai][bj][m][n]); __builtin_amdgcn_s_setprio(0); } while (0)
#define PG8_WAIT_V(n) asm volatile("s_waitcnt vmcnt(" #n ")" ::: "memory")
#define PG8_WAIT_L(n) asm volatile("s_waitcnt lgkmcnt(" #n ")" ::: "memory")
#define PG8_BAR __builtin_amdgcn_s_barrier()
#define PG8_SCHED __builtin_amdgcn_sched_barrier(0)
    Unit cur, nxt; int ui = 0;
    if (!S.next(0, cur)) return;
    f32x4 acc[2][2][4][2];
#pragma unroll
    for (int a = 0; a < 2; ++a)
#pragma unroll
        for (int b = 0; b < 2; ++b)
#pragma unroll
            for (int m = 0; m < 4; ++m)
#pragma unroll
                for (int n = 0; n < 2; ++n) acc[a][b][m][n] = (f32x4){0.f, 0.f, 0.f, 0.f};
    bf16x8 At[4][2], B0[2][2], B1[2][2];
    const char* cA = (const char*)g.A + (size_t)cur.pm * tstep; const char* cB = (const char*)g.Bt + (size_t)cur.pn * tstep;
    S.a_ready(cur);
    if constexpr (SP2) {
        PG8_STAGE(PG8_SB(0, 0), cB, voffB); PG8_STAGE(PG8_SB(0, 1), cB + hstep, voffB); PG8_STAGE(PG8_SA(0, 0), cA, voffA); PG8_STAGE(PG8_SA(0, 1), cA + hstep, voffA);
        if (wr == 1) PG8_BAR;
        PG8_WAIT_V(2); PG8_BAR;
        PG8_STAGE(PG8_SB(1, 0), cB + kstep, voffB); PG8_STAGE(PG8_SA(1, 0), cA + kstep, voffA); PG8_STAGE(PG8_SB(1, 1), cB + hstep + kstep, voffB);
        PG8_WAIT_V(6); PG8_BAR;
    } else {
        PG8_STAGE(PG8_SB(0, 0), cB, voffB); PG8_STAGE(PG8_SA(0, 0), cA, voffA); PG8_STAGE(PG8_SB(0, 1), cB + hstep, voffB); PG8_STAGE(PG8_SA(0, 1), cA + hstep, voffA);
        if (wr == 1) PG8_BAR;
        PG8_WAIT_V(4); PG8_BAR;
        PG8_STAGE(PG8_SB(1, 0), cB + kstep, voffB); PG8_STAGE(PG8_SA(1, 0), cA + kstep, voffA); PG8_STAGE(PG8_SB(1, 1), cB + hstep + kstep, voffB);
        PG8_WAIT_V(6); PG8_BAR;
    }
    for (;;) {
        const bool has_next = S.next(ui + 1, nxt);
        const char* nA = has_next ? (const char*)g.A + (size_t)nxt.pm * tstep : cA; const char* nB = has_next ? (const char*)g.Bt + (size_t)nxt.pn * tstep : cB;
        for (int t = 0; t < nt; t += 2) {
            const bool last = (t == nt - 2);
            const char* a1 = cA + (size_t)(t + 1) * kstep;
            const char* a2 = last ? nA : cA + (size_t)(t + 2) * kstep; const char* b2 = last ? nB : cB + (size_t)(t + 2) * kstep;
            const char* a3 = a2 + kstep; const char* b3 = b2 + kstep;
            if (last && has_next) S.a_ready(nxt);
            if constexpr (SP2) {
            PG8_LDB(B0, 0, 0); PG8_LDB(B1, 0, 1); PG8_SCHED; PG8_LDA(At, 0, 0); PG8_STAGE(PG8_SA(1, 1), a1 + hstep, voffA);
            PG8_WAIT_V(8); PG8_WAIT_L(0); PG8_BAR; PG8_MMA(0, 0, At, B0); PG8_MMA(0, 1, At, B1); PG8_BAR; PG8_SCHED;
            PG8_LDA(At, 0, 1); PG8_STAGE(PG8_SB(0, 0), b2, voffB); PG8_STAGE(PG8_SB(0, 1), b2 + hstep, voffB); PG8_STAGE(PG8_SA(0, 0), a2, voffA);
            PG8_WAIT_V(8); PG8_WAIT_L(0); PG8_BAR; PG8_MMA(1, 0, At, B0); PG8_MMA(1, 1, At, B1); PG8_BAR; PG8_SCHED;
            PG8_LDB(B0, 1, 0); PG8_LDB(B1, 1, 1); PG8_SCHED; PG8_LDA(At, 1, 0); PG8_STAGE(PG8_SA(0, 1), a2 + hstep, voffA);
            PG8_WAIT_V(8); PG8_WAIT_L(0); PG8_BAR; PG8_MMA(0, 0, At, B0); PG8_MMA(0, 1, At, B1); PG8_BAR; PG8_SCHED;
            PG8_LDA(At, 1, 1); PG8_STAGE(PG8_SB(1, 0), b3, voffB); PG8_STAGE(PG8_SB(1, 1), b3 + hstep, voffB); PG8_STAGE(PG8_SA(1, 0), a3, voffA);
            PG8_WAIT_V(8); PG8_WAIT_L(0); PG8_BAR; PG8_MMA(1, 0, At, B0); PG8_MMA(1, 1, At, B1); PG8_BAR; PG8_SCHED;
            } else {
            PG8_LDB(B0, 0, 0); PG8_SCHED; PG8_LDA(At, 0, 0); PG8_STAGE(PG8_SA(1, 1), a1 + hstep, voffA);
            PG8_WAIT_L(8); PG8_BAR; PG8_WAIT_L(0); PG8_MMA(0, 0, At, B0); PG8_BAR; PG8_SCHED;
            PG8_LDB(B1, 0, 1); PG8_STAGE(PG8_SB(0, 0), b2, voffB);
            PG8_BAR; PG8_WAIT_L(0); PG8_MMA(0, 1, At, B1); PG8_BAR;
            PG8_LDA(At, 0, 1); PG8_STAGE(PG8_SA(0, 0), a2, voffA);
            PG8_BAR; PG8_WAIT_L(0); PG8_MMA(1, 0, At, B0); PG8_BAR; PG8_SCHED;
            PG8_STAGE(PG8_SB(0, 1), b2 + hstep, voffB);
            PG8_WAIT_V(6); PG8_BAR; PG8_MMA(1, 1, At, B1); PG8_BAR;
            PG8_LDB(B0, 1, 0); PG8_SCHED; PG8_LDA(At, 1, 0); PG8_STAGE(PG8_SA(0, 1), a2 + hstep, voffA);
            PG8_WAIT_L(8); PG8_BAR; PG8_WAIT_L(0); PG8_MMA(0, 0, At, B0); PG8_BAR; PG8_SCHED;
            PG8_LDB(B1, 1, 1); PG8_STAGE(PG8_SB(1, 0), b3, voffB);
            PG8_BAR; PG8_WAIT_L(0); PG8_MMA(0, 1, At, B1); PG8_BAR;
            PG8_LDA(At, 1, 1); PG8_STAGE(PG8_SA(1, 0), a3, voffA);
            PG8_BAR; PG8_WAIT_L(0); PG8_MMA(1, 0, At, B0); PG8_BAR; PG8_SCHED;
            PG8_STAGE(PG8_SB(1, 1), b3 + hstep, voffB);
            PG8_WAIT_V(6); PG8_BAR; PG8_MMA(1, 1, At, B1); PG8_BAR;
            }
        }
        if constexpr (ALIGN_EPI) { if (wr == 0) PG8_BAR; }
        if constexpr (!Epi::AFTER_DRAIN) { E(acc, cur, wr, wc, fr, fq); S.done(cur); }
        if (!has_next) break;
#pragma unroll
        for (int a = 0; a < 2; ++a)
#pragma unroll
            for (int b = 0; b < 2; ++b)
#pragma unroll
                for (int m = 0; m < 4; ++m)
#pragma unroll
                    for (int n = 0; n < 2; ++n) acc[a][b][m][n] = (f32x4){0.f, 0.f, 0.f, 0.f};
        cur = nxt; cA = nA; cB = nB; ++ui;
        if constexpr (ALIGN_EPI) { if (wr == 1) PG8_BAR; }
    }
    PG8_WAIT_V(0);
    if constexpr (!ALIGN_EPI) { if (wr == 0) PG8_BAR; }
    PG8_BAR;
    if constexpr (Epi::AFTER_DRAIN) { E.fused(acc, cur, wr, wc, fr, fq, lds, wid, lane); S.done(cur); }
#undef PG8_SA
#undef PG8_SB
#undef PG8_STAGE
#undef PG8_LDA
#undef PG8_LDB
#undef PG8_MMA
#undef PG8_WAIT_V
#undef PG8_WAIT_L
#undef PG8_BAR
#undef PG8_SCHED
}
}
namespace att {
using bf16x8 = __attribute__((ext_vector_type(8))) short;
using s16x4  = __attribute__((ext_vector_type(4))) short;
using f32x16 = __attribute__((ext_vector_type(16))) float;
using f32x4  = __attribute__((ext_vector_type(4))) float;
using u32x4  = __attribute__((ext_vector_type(4))) unsigned;
typedef unsigned short bf16_t;
constexpr int S = 2048, PITCH = 512, SHM_K = 16384, SHM_V = 16384;
constexpr int OFF_XO = 0, XO_LD = 132, OFF_WS = 69632, LDS_BYTES = OFF_WS + 8 * 64 * 4;
constexpr float THR = 8.f;
#define KSWZ(row, colB) ((row) * 256 + ((colB) ^ (((row) & 7) << 4)))
#define SBAR() __builtin_amdgcn_sched_barrier(0)
__device__ __forceinline__ int crow(int r, int hi) { return (r & 3) + 8 * (r >> 2) + 4 * hi; }
__device__ __forceinline__ unsigned cvtpk(float lo, float hi) { unsigned r; asm volatile("v_cvt_pk_bf16_f32 %0, %1, %2" : "=v"(r) : "v"(lo), "v"(hi)); return r; }
__device__ __forceinline__ int v_st(int k, int c) { const int kk = (k & ~0xC) | ((k & 4) << 1) | ((k & 8) >> 1); return ((kk >> 3) * 4 + (c >> 5)) * 512 + ((kk & 7) * 32 + (c & 31)) * 2; }
__device__ __forceinline__ int v_rd_base(int lane) { return ((lane & 3) << 3) | (((lane >> 2) & 3) << 6) | (((lane >> 4) & 1) << 5) | (((lane >> 5) & 1) << 8); }
constexpr int v_rd_off(int d0, int ks, int half) { return d0 * 512 + ks * 4096 + half * 2048; }
template <int OFF> __device__ __forceinline__ s16x4 tr_read(int vb) { s16x4 r; asm volatile("ds_read_b64_tr_b16 %0, %1 offset:%2" : "=&v"(r) : "v"(vb), "i"(OFF) : "memory"); return r; }
template <int D0> __device__ __forceinline__ void pv_one(f32x16& od, int vb, bf16x8 pa0, bf16x8 pa1, bf16x8 pa2, bf16x8 pa3) {
  const s16x4 l0 = tr_read<v_rd_off(D0, 0, 0)>(vb), h0 = tr_read<v_rd_off(D0, 0, 1)>(vb), l1 = tr_read<v_rd_off(D0, 1, 0)>(vb), h1 = tr_read<v_rd_off(D0, 1, 1)>(vb);
  const s16x4 l2 = tr_read<v_rd_off(D0, 2, 0)>(vb), h2 = tr_read<v_rd_off(D0, 2, 1)>(vb), l3 = tr_read<v_rd_off(D0, 3, 0)>(vb), h3 = tr_read<v_rd_off(D0, 3, 1)>(vb);
  asm volatile("s_waitcnt lgkmcnt(0)" ::: "memory"); SBAR();
#define PKV(L, H) (bf16x8){L[0], L[1], L[2], L[3], H[0], H[1], H[2], H[3]}
  od = __builtin_amdgcn_mfma_f32_32x32x16_bf16(pa0, PKV(l0, h0), od, 0, 0, 0);
  od = __builtin_amdgcn_mfma_f32_32x32x16_bf16(pa1, PKV(l1, h1), od, 0, 0, 0);
  od = __builtin_amdgcn_mfma_f32_32x32x16_bf16(pa2, PKV(l2, h2), od, 0, 0, 0);
  od = __builtin_amdgcn_mfma_f32_32x32x16_bf16(pa3, PKV(l3, h3), od, 0, 0, 0);
#undef PKV
}
__device__ __forceinline__ void pv_d0(f32x16* o, int vb, bf16x8 pa0, bf16x8 pa1, bf16x8 pa2, bf16x8 pa3) {
  pv_one<0>(o[0], vb, pa0, pa1, pa2, pa3); pv_one<1>(o[1], vb, pa0, pa1, pa2, pa3); pv_one<2>(o[2], vb, pa0, pa1, pa2, pa3); pv_one<3>(o[3], vb, pa0, pa1, pa2, pa3);
}

__device__ __forceinline__ void attn_unit(int b, int h, int u, const bf16_t* __restrict__ Q, const bf16_t* __restrict__ K, const bf16_t* __restrict__ V, bf16_t* __restrict__ MIX,
                                          const float* __restrict__ gnorm, float lam, float sl2, char* lds) {
  int tid_ = threadIdx.x; asm volatile("" : "+v"(tid_));
  const int tid = tid_, lane = tid & 63, r32 = lane & 31, hi = lane >> 5;
  const int wid = __builtin_amdgcn_readfirstlane(tid >> 6);
  const int c = wid >> 2, rb = wid & 3;
  const int q0 = u * 128, mychunk = 2 * u + (rb >> 1), NT = 2 * u + 2;
  const int qpos = q0 + rb * 32 + r32;
  const size_t rowbase = (size_t)b * S;
  char* V_lds = lds; char* K_lds = lds + 2 * SHM_V;
  float* ws = (float*)(lds + OFF_WS) + wid * 64;
  bf16x8 qr[4];
  { const bf16_t* Qw = Q + (rowbase + qpos) * PITCH + h * 128 + c * 64 + hi * 8;
#pragma unroll
    for (int d0 = 0; d0 < 4; ++d0) qr[d0] = *reinterpret_cast<const bf16x8*>(Qw + d0 * 16); }
  const int sr = tid >> 4, sc = (tid & 15) * 8;
  const int vst0 = v_st(sr, sc), vst1 = v_st(32 + sr, sc);
  const int kst0 = KSWZ(sr, sc * 2), kst1 = KSWZ(32 + sr, sc * 2);
  const int vb0 = (int)(uintptr_t)V_lds + v_rd_base(lane);
  const bf16_t* Kg = K + rowbase * PITCH + h * 128 + sc; const bf16_t* Vg = V + rowbase * PITCH + h * 128 + sc;
  bf16x8 vs0, vs1, ks0, ks1;
#define SLOAD(k0) do { vs0 = *reinterpret_cast<const bf16x8*>(Vg + (size_t)((k0) + sr) * PITCH); vs1 = *reinterpret_cast<const bf16x8*>(Vg + (size_t)((k0) + 32 + sr) * PITCH); \
    ks0 = *reinterpret_cast<const bf16x8*>(Kg + (size_t)((k0) + sr) * PITCH); ks1 = *reinterpret_cast<const bf16x8*>(Kg + (size_t)((k0) + 32 + sr) * PITCH); } while (0)
#define SWRITE(bf) do { *(bf16x8*)(V_lds + (bf) * SHM_V + vst0) = vs0; *(bf16x8*)(V_lds + (bf) * SHM_V + vst1) = vs1; \
    *(bf16x8*)(K_lds + (bf) * SHM_K + kst0) = ks0; *(bf16x8*)(K_lds + (bf) * SHM_K + kst1) = ks1; } while (0)
  float m = 0.f, l = 0.f; f32x16 o[4];
#pragma unroll
  for (int d = 0; d < 4; ++d) o[d] = f32x16{};
  bool started = false;
  SLOAD((NT - 1) * 64); SWRITE(0); __syncthreads();
#pragma unroll 1
  for (int it = 0; it < NT; ++it) {
    const int j = NT - 1 - it, bf = it & 1;
    if (it + 1 < NT) SLOAD((j - 1) * 64);
    if (j <= mychunk) {
      f32x16 p0, p1;
      if (j != mychunk) { const float t0 = sl2 * (float)(64 * j + 4 * hi - qpos) - m;
#pragma unroll
        for (int r = 0; r < 16; ++r) { p0[r] = fmaf(sl2, (float)((r & 3) + 8 * (r >> 2)), t0); p1[r] = p0[r] + 32.f * sl2; } }
      else {
#pragma unroll
        for (int r = 0; r < 16; ++r) { const float d = (float)(64 * j + crow(r, hi) - qpos); p0[r] = -sl2 * fabsf(d) - m; p1[r] = -sl2 * fabsf(d + 32.f) - m; } }
      const char* Kb = K_lds + bf * SHM_K;
      __builtin_amdgcn_s_setprio(1);
#pragma unroll
      for (int d0 = 0; d0 < 4; ++d0) { const int cbb = ((c * 4 + d0) * 16 + hi * 8) * 2;
        const bf16x8 b0 = *reinterpret_cast<const bf16x8*>(Kb + KSWZ(r32, cbb));
        const bf16x8 b1 = *reinterpret_cast<const bf16x8*>(Kb + KSWZ(32 + r32, cbb));
        p0 = __builtin_amdgcn_mfma_f32_32x32x16_bf16(b0, qr[d0], p0, 0, 0, 0);
        p1 = __builtin_amdgcn_mfma_f32_32x32x16_bf16(b1, qr[d0], p1, 0, 0, 0); }
      __builtin_amdgcn_s_setprio(0);
      float pmax = p0[0];
#pragma unroll
      for (int r = 1; r < 16; ++r) pmax = fmaxf(pmax, p0[r]);
#pragma unroll
      for (int r = 0; r < 16; ++r) pmax = fmaxf(pmax, p1[r]);
      { auto rr = __builtin_amdgcn_permlane32_swap(__float_as_uint(pmax), __float_as_uint(pmax), false, false); pmax = fmaxf(__uint_as_float(rr[0]), __uint_as_float(rr[1])); }
      if (!started) { started = true; m += pmax;
#pragma unroll
        for (int r = 0; r < 16; ++r) { p0[r] -= pmax; p1[r] -= pmax; } }
      else if (__any(pmax > THR)) { const float delta = fmaxf(pmax, 0.f); m += delta;
#pragma unroll
        for (int r = 0; r < 16; ++r) { p0[r] -= delta; p1[r] -= delta; }
        const float alpha = __builtin_amdgcn_exp2f(-delta); l *= alpha;
        if (hi == 0) ws[r32] = alpha;
        asm volatile("s_waitcnt lgkmcnt(0)" ::: "memory");
#pragma unroll
        for (int r = 0; r < 16; ++r) { const float a = ws[crow(r, hi)];
#pragma unroll
          for (int d = 0; d < 4; ++d) o[d][r] *= a; } }
#pragma unroll
      for (int r = 0; r < 16; ++r) { p0[r] = __builtin_amdgcn_exp2f(p0[r]); p1[r] = __builtin_amdgcn_exp2f(p1[r]); }
      float ps = 0.f;
#pragma unroll
      for (int r = 0; r < 16; ++r) ps += p0[r];
#pragma unroll
      for (int r = 0; r < 16; ++r) ps += p1[r];
      { auto rr = __builtin_amdgcn_permlane32_swap(__float_as_uint(ps), __float_as_uint(ps), false, false); ps = __uint_as_float(rr[0]) + __uint_as_float(rr[1]); }
      l += ps;
      bf16x8 pa0, pa1, pa2, pa3;
#define PK4(P, BASE, OUT) do { unsigned a0 = cvtpk(P[BASE + 0], P[BASE + 1]), a1 = cvtpk(P[BASE + 2], P[BASE + 3]);   \
    unsigned b0_ = cvtpk(P[BASE + 4], P[BASE + 5]), b1_ = cvtpk(P[BASE + 6], P[BASE + 7]);                              \
    auto r0 = __builtin_amdgcn_permlane32_swap(a0, b0_, false, false); auto r1 = __builtin_amdgcn_permlane32_swap(a1, b1_, false, false); \
    u32x4 w = {r0[0], r1[0], r0[1], r1[1]}; OUT = __builtin_bit_cast(bf16x8, w); } while (0)
      PK4(p0, 0, pa0); PK4(p0, 8, pa1); PK4(p1, 0, pa2); PK4(p1, 8, pa3);
#undef PK4
      __builtin_amdgcn_s_setprio(1); pv_d0(o, vb0 + bf * SHM_V, pa0, pa1, pa2, pa3); __builtin_amdgcn_s_setprio(0);
    }
    if (it + 1 < NT) SWRITE(bf ^ 1);
    __syncthreads();
  }
#undef SLOAD
#undef SWRITE
  if (hi == 0) ws[r32] = l;
  asm volatile("s_waitcnt lgkmcnt(0)" ::: "memory");
  float rli[16];
#pragma unroll
  for (int r = 0; r < 16; ++r) rli[r] = 1.f / ws[crow(r, hi)];
  float* XO = (float*)(lds + OFF_XO) + rb * (32 * XO_LD);
  if (c == 1) {
#pragma unroll
    for (int r = 0; r < 16; ++r)
#pragma unroll
      for (int d0 = 0; d0 < 4; ++d0) XO[crow(r, hi) * XO_LD + d0 * 32 + r32] = lam * o[d0][r] * rli[r];
  }
  __syncthreads();
  if (c == 0) {
#pragma unroll
    for (int r = 0; r < 16; ++r)
#pragma unroll
      for (int d0 = 0; d0 < 4; ++d0) { float* p = &XO[crow(r, hi) * XO_LD + d0 * 32 + r32]; *p = o[d0][r] * rli[r] - *p; }
    asm volatile("s_waitcnt lgkmcnt(0)" ::: "memory");
    const int row = lane >> 1, half = lane & 1; const float* rp = XO + row * XO_LD + half * 64;
    f32x4 v[16]; float ss = 0.f;
#pragma unroll
    for (int i = 0; i < 16; ++i) { v[i] = *(const f32x4*)(rp + 4 * i); ss += (v[i][0] * v[i][0] + v[i][1] * v[i][1]) + (v[i][2] * v[i][2] + v[i][3] * v[i][3]); }
    ss += __builtin_bit_cast(float, __builtin_amdgcn_update_dpp(0, __builtin_bit_cast(int, ss), 0xB1, 0xf, 0xf, false));
    const float rn = 0.8f / sqrtf(ss * (1.f / 128.f) + 1e-6f);
    bf16_t* op = MIX + (rowbase + q0 + rb * 32 + row) * 1024 + h * 128 + half * 64;
    const float* gp = gnorm + half * 64;
#pragma unroll
    for (int k = 0; k < 8; ++k) { const f32x4 ga = *(const f32x4*)(gp + 8 * k), gb = *(const f32x4*)(gp + 8 * k + 4); const f32x4 a = v[2 * k] * ga * rn, bq = v[2 * k + 1] * gb * rn;
      u32x4 w; w.x = cvtpk(a[0], a[1]); w.y = cvtpk(a[2], a[3]); w.z = cvtpk(bq[0], bq[1]); w.w = cvtpk(bq[2], bq[3]); *(u32x4*)(op + 8 * k) = w; }
  }
  __syncthreads();
}
#undef KSWZ
#undef SBAR
}

#define GAS __attribute__((address_space(1)))
#define LAS __attribute__((address_space(3)))
typedef unsigned short bf16;
typedef unsigned v4u __attribute__((ext_vector_type(4)));
typedef float f32x4 __attribute__((ext_vector_type(4)));
typedef short bf16x8 __attribute__((ext_vector_type(8)));
typedef GAS unsigned gu32;
typedef GAS unsigned long long gu64;
#define RLX_AGENT __ATOMIC_RELAXED, __HIP_MEMORY_SCOPE_AGENT
#define LDS_WAIT() asm volatile("s_waitcnt lgkmcnt(0)" ::: "memory")
#define VM_WAIT() asm volatile("s_waitcnt vmcnt(0)" ::: "memory")
__device__ __forceinline__ unsigned long long rt() { return __builtin_amdgcn_s_memrealtime(); }
__device__ __forceinline__ unsigned f2bf(float f) { unsigned u = __builtin_bit_cast(unsigned, f); return (u + 0x7fffu + ((u >> 16) & 1u)) >> 16; }
__device__ __forceinline__ unsigned pk2(float lo, float hi) { return f2bf(lo) | (f2bf(hi) << 16); }

#define XB_TMO      128
#define XB_XCNT(j)  (256  + 64 * (j))
#define XB_XSUB(j)  (1280 + 64 * (j))
#define XB_XGEN(j)  (2304 + 64 * (j))
#define XB_TOP      3328
#define XB_TOPGEN   3392
#define XCD_BAR_WORDS 3456
#define XB_SPIN_CAP (1u << 18)

__device__ __forceinline__ unsigned xb_ld(unsigned* p)              { return __hip_atomic_load(p, __ATOMIC_RELAXED, __HIP_MEMORY_SCOPE_AGENT); }
__device__ __forceinline__ unsigned xb_add(unsigned* p, unsigned v) { return __hip_atomic_fetch_add(p, v, __ATOMIC_RELAXED, __HIP_MEMORY_SCOPE_AGENT); }
__device__ __forceinline__ unsigned xb_xcc_id() { return (unsigned)__builtin_amdgcn_s_getreg((3 << 11) | 20) & 0xFu; }
#define XB_SPIN(cond, bar) do { unsigned _sp = 0; while (cond) { __builtin_amdgcn_s_sleep(1); \
    if ((++_sp & 255u) == 0u) { if (xb_ld(&(bar)[XB_TMO])) break; if (_sp > XB_SPIN_CAP) { atomicAdd(&(bar)[XB_TMO], 1u); break; } } } } while (0)

struct XcdBarrier {
    unsigned* bar; unsigned x;
    volatile LAS unsigned* st;
};

__device__ __forceinline__ XcdBarrier xcd_barrier_post(unsigned* bar, volatile LAS unsigned* st) {
    XcdBarrier b; b.bar = bar; b.x = xb_xcc_id(); b.st = st;
    if (threadIdx.x == 0) (void)xb_add(&bar[XB_XCNT(b.x)], 1u);
    return b;
}
__device__ __forceinline__ void xcd_barrier_complete(unsigned* bar, unsigned x, unsigned& nloc, unsigned& nx) {
    const unsigned G = gridDim.x * gridDim.y * gridDim.z;
    unsigned sum, cnt, mine, sp = 0u;
    for (;;) {
        sum = 0u; cnt = 0u; mine = 0u;
#pragma unroll
        for (unsigned j = 0; j < 16; ++j) { const unsigned c = xb_ld(&bar[XB_XCNT(j)]); sum += c; cnt += (c > 0u) ? 1u : 0u; mine = (j == x) ? c : mine; }
        if (sum == G) break;
        __builtin_amdgcn_s_sleep(1);
        if ((++sp & 255u) == 0u) { if (xb_ld(&bar[XB_TMO])) break; if (sp > XB_SPIN_CAP) { atomicAdd(&bar[XB_TMO], 1u); break; } }
    }
    nloc = mine > 0u ? mine : 1u; nx = cnt > 0u ? cnt : 1u;
}

__device__ __forceinline__ void xcd_barrier(const XcdBarrier& b) {
    asm volatile("s_waitcnt vmcnt(0)" ::: "memory");
    __syncthreads();
    if (threadIdx.x == 0) {
        unsigned* bar = b.bar;
        __builtin_amdgcn_s_waitcnt(0);
        unsigned nloc = b.st[0], nx = b.st[1];
        if (nloc == 0u) { xcd_barrier_complete(bar, b.x, nloc, nx); b.st[0] = nloc; b.st[1] = nx; }
        const unsigned old = xb_add(&bar[XB_XSUB(b.x)], 1u);
        const unsigned gen = old / nloc;
        if (old + 1u == (gen + 1u) * nloc) {
            __builtin_amdgcn_fence(__ATOMIC_RELEASE, "agent");
            asm volatile("s_waitcnt vmcnt(0)" ::: "memory");
            const unsigned og = xb_add(&bar[XB_TOP], 1u);
            const unsigned tg = og / nx;
            if (og + 1u == (tg + 1u) * nx) xb_add(&bar[XB_TOPGEN], 1u);
            else XB_SPIN(xb_ld(&bar[XB_TOPGEN]) == tg, bar);
            __builtin_amdgcn_fence(__ATOMIC_ACQUIRE, "agent");
            asm volatile("s_waitcnt vmcnt(0)" ::: "memory");
        } else {
            XB_SPIN(xb_ld(&bar[XB_TOPGEN]) == gen, bar);
            __builtin_amdgcn_fence(__ATOMIC_ACQUIRE, "agent");
            asm volatile("s_waitcnt vmcnt(0)" ::: "memory");
        }
    }
    __syncthreads();
}
constexpr int NWAVES = 8;
constexpr int N_LAUNCHES = MK_N_LAUNCHES;
constexpr int N_PHASES = 12;
constexpr int BATCH = 16, SEQ = 2048, DM = 1024, T = BATCH * SEQ;
constexpr int IN_COLS = 3072, NEXP = 16384;
constexpr float EPS = 1e-6f;
constexpr size_t MiB = 1u << 20;
constexpr size_t WS_CTL = 0, CTL_ZERO_BYTES = 1 * MiB;
constexpr size_t WS_MODP = 20 * MiB;
constexpr int NKC = 16;
constexpr size_t WS_MOD = 4 * MiB;
constexpr size_t WS_WIN = 8 * MiB, WS_WO = 14 * MiB, WS_WK = 16 * MiB;
constexpr size_t WS_U8 = 32 * MiB, WS_V8 = 48 * MiB;
constexpr float USCALE = 800.f, VSCALE = 70.f;
constexpr size_t WS_WKF = 160 * MiB;
constexpr size_t WS_WINF = 168 * MiB, WS_WOF = 180 * MiB;
constexpr size_t WS_WKS = 7 * MiB, WS_WINS = 7 * MiB + 16384, WS_WOS = 7 * MiB + 32768;
constexpr size_t WS_WSC = 6 * MiB;
constexpr size_t WS_H8 = 64 * MiB;
constexpr size_t WS_HS = 5 * MiB;
constexpr size_t WS_Y = 384 * MiB;
constexpr size_t WS_PART = 224 * MiB;
constexpr size_t WS_W = 352 * MiB;
constexpr size_t WS_H = 96 * MiB;
constexpr size_t WS_DELTA = 448 * MiB;
constexpr size_t WS_IDX = 192 * MiB, WS_GW = 208 * MiB;
constexpr size_t WS_Q = 224 * MiB, WS_K = 256 * MiB, WS_VV = 288 * MiB, WS_CB = 320 * MiB, WS_GC = 352 * MiB;
constexpr size_t WS_MIX = 384 * MiB;
constexpr size_t WS_SC = 224 * MiB;
constexpr size_t WS_END = 512 * MiB;
constexpr int CW_BAR = 4096, CW_XRANK = 2048;
constexpr int RING_BYTES = 131072, LDSCTL_OFF = RING_BYTES, MISC_OFF = LDSCTL_OFF + 320, LDS_BYTES = 147456;

typedef __bf16 bf16x2_t __attribute__((ext_vector_type(2)));
__device__ __forceinline__ float bflo(unsigned w) { return __uint_as_float(w << 16); }
__device__ __forceinline__ float bfhi(unsigned w) { return __uint_as_float(w & 0xffff0000u); }
__device__ __forceinline__ float dot2bf(unsigned a, unsigned b, float acc) { return __builtin_amdgcn_fdot2_f32_bf16(__builtin_bit_cast(bf16x2_t, a), __builtin_bit_cast(bf16x2_t, b), acc, false); }
#define DPPF(X, CTRL) __builtin_bit_cast(float, __builtin_amdgcn_update_dpp(0, __builtin_bit_cast(int, (X)), (CTRL), 0xf, 0xf, false))
__device__ __forceinline__ float row16_sum(float v) { v += DPPF(v, 0xB1); v += DPPF(v, 0x4E); v += DPPF(v, 0x141); v += DPPF(v, 0x140); return v; }
__device__ __forceinline__ float row16_max(float v) { v = fmaxf(v, DPPF(v, 0xB1)); v = fmaxf(v, DPPF(v, 0x4E)); v = fmaxf(v, DPPF(v, 0x141)); v = fmaxf(v, DPPF(v, 0x140)); return v; }
__device__ __forceinline__ float wave_sum(float v) {
    v = row16_sum(v);
    { const unsigned u = __builtin_bit_cast(unsigned, v); const auto s = __builtin_amdgcn_permlane16_swap(u, u, false, false); v = __builtin_bit_cast(float, (unsigned)s[0]) + __builtin_bit_cast(float, (unsigned)s[1]); }
    { const unsigned u = __builtin_bit_cast(unsigned, v); const auto s = __builtin_amdgcn_permlane32_swap(u, u, false, false); v = __builtin_bit_cast(float, (unsigned)s[0]) + __builtin_bit_cast(float, (unsigned)s[1]); }
    return v;
}
__device__ __forceinline__ float wave_max(float v) {
    v = row16_max(v);
    { const unsigned u = __builtin_bit_cast(unsigned, v); const auto s = __builtin_amdgcn_permlane16_swap(u, u, false, false); v = fmaxf(__builtin_bit_cast(float, (unsigned)s[0]), __builtin_bit_cast(float, (unsigned)s[1])); }
    { const unsigned u = __builtin_bit_cast(unsigned, v); const auto s = __builtin_amdgcn_permlane32_swap(u, u, false, false); v = fmaxf(__builtin_bit_cast(float, (unsigned)s[0]), __builtin_bit_cast(float, (unsigned)s[1])); }
    return v;
}
#ifndef ATT_REP
#define ATT_REP 1
#endif
struct Args { const float* in[20]; float* out; unsigned char* ws; int ph_lo, ph_hi, li, pad; };
struct Frame {
    LAS unsigned char* lds; unsigned char* ldsg;
    int tid, lane, wave, vcu, G, gw, NGW, xcc, xrank;
};

__device__ __forceinline__ void tab_store_i8(unsigned char* tab, int e, int q, int lane, f32x4 y) {
    int b0 = (int)__builtin_rintf(y[0]), b1 = (int)__builtin_rintf(y[1]), b2 = (int)__builtin_rintf(y[2]), b3 = (int)__builtin_rintf(y[3]);
    b0 = b0 < -127 ? -127 : (b0 > 127 ? 127 : b0); b1 = b1 < -127 ? -127 : (b1 > 127 ? 127 : b1); b2 = b2 < -127 ? -127 : (b2 > 127 ? 127 : b2); b3 = b3 < -127 ? -127 : (b3 > 127 ? 127 : b3);
    const unsigned w = ((unsigned)b0 & 0xffu) | (((unsigned)b1 & 0xffu) << 8) | (((unsigned)b2 & 0xffu) << 16) | ((unsigned)b3 << 24);
    *(GAS unsigned*)(tab + (size_t)(2 * q + (lane >> 5)) * ((size_t)NEXP * 128) + (size_t)e * 128 + ((4 * lane) & 127)) = w;
}
__device__ __forceinline__ void transpose_item(const float* W, int K, int N, float* WT, int k0, int n0, int out_row0, LAS float* scr, int lane) {
#pragma unroll
    for (int i = 0; i < 32; ++i) { const int kk = 2 * i + (lane >> 5); scr[kk * 33 + (lane & 31)] = __builtin_nontemporal_load(W + (size_t)(k0 + kk) * N + n0 + (lane & 31)); }
    LDS_WAIT(); asm volatile("" ::: "memory");
    const int c = lane & 7;
#pragma unroll
    for (int j = 0; j < 4; ++j) { const int n = (lane >> 3) + 8 * j; const LAS float* s = scr + (8 * c) * 33 + n;
        GAS f32x4* op = (GAS f32x4*)(WT + (size_t)(out_row0 + n) * K + k0 + 8 * c);
        op[0] = (f32x4){s[0 * 33], s[1 * 33], s[2 * 33], s[3 * 33]}; op[1] = (f32x4){s[4 * 33], s[5 * 33], s[6 * 33], s[7 * 33]}; }
    LDS_WAIT(); asm volatile("" ::: "memory");
}
__device__ __forceinline__ int win_row(int n) {
    if (n < 2048) return n;
    if (n < 2560) { const int j = n - 2048; return (8 + (j >> 7)) * 256 + (j & 127); }
    const int j = n - 2560; return (8 + (j >> 7)) * 256 + 128 + (j & 127);
}
__device__ __forceinline__ void phase0(const Frame& F, const Args& a) {
    const float* c = a.in[1]; const float* ada_w = a.in[2];
    const float* w_in = a.in[5]; const float* w_o = a.in[13]; const float* wq = a.in[15]; const float* keys = a.in[16];
    unsigned char* ws = a.ws;
    const int lane = F.lane;
    const int rgw = F.gw, RNGW = F.NGW;
    {
        typedef float f32x16_t __attribute__((ext_vector_type(16)));
        float* WK = (float*)(ws + WS_WKF);
        const int l31 = lane & 31, lh = lane >> 5;
        for (int it = rgw; it < 16 * 4 * 32; it += RNGW) {
            const int hp = it >> 7, n0 = ((it >> 5) & 3) * 32, k0 = (it & 31) * 32;
            const GAS f32x4* ka = (const GAS f32x4*)(keys + (size_t)hp * 16384 + (size_t)(n0 + l31) * 128 + 64 * lh);
            const GAS f32x4* kb = (const GAS f32x4*)(wq + (size_t)(k0 + l31) * 2048 + hp * 128 + 64 * lh);
            f32x4 av[16], bv[16];
#pragma unroll
            for (int q = 0; q < 16; ++q) { av[q] = ka[q]; bv[q] = kb[q]; }
            f32x16_t acc = {};
#pragma unroll
            for (int q = 0; q < 16; ++q) {
                acc = __builtin_amdgcn_mfma_f32_32x32x2f32(av[q][0], bv[q][0], acc, 0, 0, 0); acc = __builtin_amdgcn_mfma_f32_32x32x2f32(av[q][1], bv[q][1], acc, 0, 0, 0);
                acc = __builtin_amdgcn_mfma_f32_32x32x2f32(av[q][2], bv[q][2], acc, 0, 0, 0); acc = __builtin_amdgcn_mfma_f32_32x32x2f32(av[q][3], bv[q][3], acc, 0, 0, 0); }
            float* op = WK + (size_t)(hp * 128 + n0) * 1024 + k0 + l31;
#pragma unroll
            for (int r = 0; r < 16; ++r) op[(size_t)((r & 3) + 8 * (r >> 2) + 4 * lh) * 1024] = acc[r];
        }
    }
    LAS float* scr = (LAS float*)(F.lds + F.wave * 16384);
    {
        float* MODP = (float*)(ws + WS_MODP);
        for (int it = rgw; it < NKC * 96; it += RNGW) {
            const int kc = it / 96, cc = it % 96, col = cc * 64 + lane;
            const float* wp = ada_w + (size_t)(kc * 64) * 6144 + col;
            float cvv[16], w[64];
#pragma unroll
            for (int b = 0; b < 16; ++b) cvv[b] = c[b * 1024 + kc * 64 + lane];
#pragma unroll
            for (int k = 0; k < 64; ++k) w[k] = __builtin_nontemporal_load(wp + (size_t)k * 6144);
#pragma unroll
            for (int b = 0; b < 16; ++b) scr[b * 64 + lane] = cvv[b] / (1.f + expf(-cvv[b]));
            LDS_WAIT(); asm volatile("" ::: "memory");
            float acc[16];
#pragma unroll
            for (int b = 0; b < 16; ++b) acc[b] = 0.f;
#pragma unroll
            for (int k = 0; k < 64; ++k)
#pragma unroll
                for (int b = 0; b < 16; ++b) acc[b] = fmaf(scr[b * 64 + k], w[k], acc[b]);
#pragma unroll
            for (int b = 0; b < 16; ++b) MODP[(size_t)(kc * 16 + b) * 6144 + col] = acc[b];
            LDS_WAIT(); asm volatile("" ::: "memory");
        }
    }
    {
        float* WIN = (float*)(ws + WS_WINF); float* WO = (float*)(ws + WS_WOF);
        constexpr int I_IN = 16 * 96, I_O = 16 * 32;
        for (int it = rgw; it < I_IN + I_O; it += RNGW) {
            if (it < I_IN) { const int kb = it / 96, nb = it % 96; transpose_item(w_in, 1024, 3072, WIN, kb * 64, nb * 32, win_row(nb * 32), scr, lane); }
            else { const int r = it - I_IN, kb = r / 32, nb = r % 32; transpose_item(w_o, 1024, 1024, WO, kb * 64, nb * 32, nb * 32, scr, lane); }
        }
    }
}

template <bool FROM_PARTIALS, bool ADD_DELTA, bool QUANT8>
__device__ __forceinline__ void norm_rows(const Frame& F, const float* __restrict__ src, const bf16* __restrict__ delta, bf16* __restrict__ dst, unsigned* __restrict__ dst8, float* __restrict__ hs, const float* __restrict__ gvec, const float* __restrict__ modsrc  ,
                                          const float* __restrict__ ada_b, int sh_off, int sc_off) {
    LAS float* sS = (LAS float*)F.lds; LAS float* sH = sS + 1024;
    for (int rb = F.vcu; rb < T / 128; rb += F.G) {
        const int b = rb >> 4;
        {
            const int k0 = F.tid, k1 = F.tid + 512;
            float sc0, sh0, sc1, sh1;
            if (FROM_PARTIALS) {
                float pc0[NKC], ph0[NKC], pc1[NKC], ph1[NKC];
#pragma unroll
                for (int kc = 0; kc < NKC; ++kc) { const float* m = modsrc + (size_t)(kc * 16 + b) * 6144; pc0[kc] = m[sc_off + k0]; ph0[kc] = m[sh_off + k0]; pc1[kc] = m[sc_off + k1]; ph1[kc] = m[sh_off + k1]; }
                sc0 = ada_b[sc_off + k0]; sh0 = ada_b[sh_off + k0]; sc1 = ada_b[sc_off + k1]; sh1 = ada_b[sh_off + k1];
#pragma unroll
                for (int kc = 0; kc < NKC; ++kc) { sc0 += pc0[kc]; sh0 += ph0[kc]; sc1 += pc1[kc]; sh1 += ph1[kc]; }
            } else { const float* m = modsrc + (size_t)b * 6144; sc0 = m[sc_off + k0]; sh0 = m[sh_off + k0]; sc1 = m[sc_off + k1]; sh1 = m[sh_off + k1]; }
            const float g0 = gvec[k0], g1 = gvec[k1];
            sS[k0] = g0 * (1.f + sc0); sH[k0] = sh0; sS[k1] = g1 * (1.f + sc1); sH[k1] = sh1;
        }
        __syncthreads();
        for (int i = 0; i < 16; ++i) {
            const int row = rb * 128 + F.wave * 16 + i;
            const GAS f32x4* xr = (const GAS f32x4*)(src + (size_t)row * 1024) + F.lane;
            f32x4 v[4]; float s = 0.f;
#pragma unroll
            for (int j = 0; j < 4; ++j) { v[j] = __builtin_nontemporal_load(xr + 64 * j);
                if (ADD_DELTA) { const unsigned long long dd = __builtin_nontemporal_load((const GAS unsigned long long*)(delta + (size_t)row * 1024) + F.lane + 64 * j); const unsigned dlo = (unsigned)dd, dhi = (unsigned)(dd >> 32);
                    v[j] = v[j] + (f32x4){bflo(dlo), bfhi(dlo), bflo(dhi), bfhi(dhi)};
                    __builtin_nontemporal_store((unsigned long long)pk2(v[j].x, v[j].y) | ((unsigned long long)pk2(v[j].z, v[j].w) << 32), (GAS unsigned long long*)(dst + (size_t)row * 1024) + F.lane + 64 * j); }
                s += (v[j].x * v[j].x + v[j].y * v[j].y) + (v[j].z * v[j].z + v[j].w * v[j].w); }
            const float tot = wave_sum(s);
            const float r = 1.f / sqrtf(tot * (1.f / 1024.f) + EPS);
            GAS unsigned long long* o8 = (GAS unsigned long long*)(dst + (size_t)row * 1024) + F.lane;
#pragma unroll
            for (int j = 0; j < 4; ++j) { const int k = 4 * F.lane + 256 * j; const f32x4 sc = *(const LAS f32x4*)(sS + k), sh = *(const LAS f32x4*)(sH + k);
                const f32x4 y = v[j] * r * sc + sh; v[j] = y;
                if (!QUANT8) o8[64 * j] = (unsigned long long)pk2(y.x, y.y) | ((unsigned long long)pk2(y.z, y.w) << 32); }
            if (QUANT8) {
                float mx = 0.f;
#pragma unroll
                for (int j = 0; j < 4; ++j) mx = fmaxf(fmaxf(mx, fmaxf(fabsf(v[j].x), fabsf(v[j].y))), fmaxf(fabsf(v[j].z), fabsf(v[j].w)));
                mx = wave_max(mx);
                mx = fmaxf(mx, 1e-20f); const float inv = 127.f / mx;
#pragma unroll
                for (int j = 0; j < 4; ++j) { const int b0 = (int)__builtin_rintf(v[j].x * inv), b1 = (int)__builtin_rintf(v[j].y * inv), b2 = (int)__builtin_rintf(v[j].z * inv), b3 = (int)__builtin_rintf(v[j].w * inv);
                    dst8[(size_t)row * 256 + F.lane + 64 * j] = ((unsigned)b0 & 0xffu) | (((unsigned)b1 & 0xffu) << 8) | (((unsigned)b2 & 0xffu) << 16) | ((unsigned)b3 << 24); }
                if (F.lane == 0) hs[row] = mx * (1.f / 127.f);
            }
        }
        __syncthreads();
    }
}
__device__ __forceinline__ void phase1(const Frame& F, const Args& a) {
    unsigned char* ws = a.ws;
    norm_rows<true, false, true>(F, a.in[0], nullptr, (bf16*)(ws + WS_H), (unsigned*)(ws + WS_H8), (float*)(ws + WS_HS), a.in[4], (const float*)(ws + WS_MODP), a.in[3], 0, 1024);
    { const float* WKF = (const float*)(ws + WS_WKF); const float* WINF = (const float*)(ws + WS_WINF); const float* WOF = (const float*)(ws + WS_WOF);
      for (int n = F.gw; n < 2048 + 3072 + 1024; n += F.NGW) {
          const bool isk = n < 2048, isin = !isk && n < 5120; const int r = isk ? n : (isin ? n - 2048 : n - 5120);
          const float* src = (isk ? WKF : (isin ? WINF : WOF)) + (size_t)r * 1024;
          const GAS f32x4* rp = (const GAS f32x4*)src + F.lane; f32x4 v[4];
#pragma unroll
          for (int j = 0; j < 4; ++j) v[j] = __builtin_nontemporal_load(rp + 64 * j);
          if (!isk && !isin) {
              GAS unsigned long long* o8 = (GAS unsigned long long*)((bf16*)(ws + WS_WO) + (size_t)r * 1024) + F.lane;
#pragma unroll
              for (int j = 0; j < 4; ++j) o8[64 * j] = (unsigned long long)pk2(v[j].x, v[j].y) | ((unsigned long long)pk2(v[j].z, v[j].w) << 32);
              continue; }
          float mx = 0.f;
#pragma unroll
          for (int j = 0; j < 4; ++j) mx = fmaxf(fmaxf(mx, fmaxf(fabsf(v[j].x), fabsf(v[j].y))), fmaxf(fabsf(v[j].z), fabsf(v[j].w)));
          mx = wave_max(mx);
          mx = fmaxf(mx, 1e-30f); const float inv = 127.f / mx;
          unsigned* dst = (unsigned*)(ws + (isk ? WS_WK : WS_WIN)) + (size_t)r * 256;
#pragma unroll
          for (int j = 0; j < 4; ++j) { const int b0 = (int)__builtin_rintf(v[j].x * inv), b1 = (int)__builtin_rintf(v[j].y * inv), b2 = (int)__builtin_rintf(v[j].z * inv), b3 = (int)__builtin_rintf(v[j].w * inv);
              dst[F.lane + 64 * j] = ((unsigned)b0 & 0xffu) | (((unsigned)b1 & 0xffu) << 8) | (((unsigned)b2 & 0xffu) << 16) | ((unsigned)b3 << 24); }
          if (F.lane == 0) ((float*)(ws + (isk ? WS_WKS : WS_WINS)))[r] = mx * (1.f / 127.f);
      } }
    const float* MODP = (const float*)(ws + WS_MODP); float* MOD = (float*)(ws + WS_MOD);
    for (int i = F.vcu * 512 + F.tid; i < 16 * 6144; i += F.G * 512) { float s = a.in[3][i % 6144];
#pragma unroll
        for (int kc = 0; kc < NKC; ++kc) s += MODP[(size_t)kc * 98304 + i];
        MOD[i] = s; }
}

__device__ __forceinline__ void phase3(const Frame& F, const Args& a) {
    unsigned char* ws = a.ws;
    const bf16* Q = (const bf16*)(ws + WS_Q); const bf16* K = (const bf16*)(ws + WS_K); const bf16* V = (const bf16*)(ws + WS_VV);
    bf16* MIX = (bf16*)(ws + WS_MIX);
    float lam;
    { float p = a.in[7][F.lane] * a.in[8][F.lane], q = a.in[9][F.lane] * a.in[10][F.lane]; p = wave_sum(p); q = wave_sum(q); lam = expf(p) - expf(q) + 0.2f; }
    for (int v = F.vcu; v < 256; v += F.G) {
        const int bh = v >> 2, s = v & 3, b = bh >> 2, h = bh & 3;
        const float sl2 = exp2f(-2.f * (float)(h + 1)) * 1.4426950408889634f;
        for (int i_ = 0; i_ < 4 * ATT_REP; ++i_) { const int i = i_ & 3; const int u = (i == 0) ? 15 - s : (i == 1) ? 8 + s : (i == 2) ? 7 - s : s;
            att::attn_unit(b, h, u, Q, K, V, MIX, a.in[11] + h * 128, lam, sl2, (char*)F.ldsg); }
    }
    const bf16* CB = (const bf16*)(ws + WS_CB); const bf16* GC = (const bf16*)(ws + WS_GC);
    const float* cw = a.in[6]; const float* cg = a.in[12];
    const int c0 = 8 * F.lane;
    float w0[8], w1[8], w2[8], gn[8];
#pragma unroll
    for (int k = 0; k < 8; ++k) { w0[k] = cw[c0 + k]; w1[k] = cw[512 + c0 + k]; w2[k] = cw[1024 + c0 + k]; gn[k] = cg[c0 + k]; }
    for (int tg = F.gw; tg < T / 16; tg += F.NGW) {
        const int t0 = tg * 16; const bool first = (t0 % SEQ) == 0;
        float g2[8], g1[8];
        if (first) {
#pragma unroll
            for (int k = 0; k < 8; ++k) { g2[k] = 0.f; g1[k] = 0.f; } }
        else { const v4u a2 = *(const GAS v4u*)(GC + (size_t)(t0 - 2) * 512 + c0), a1 = *(const GAS v4u*)(GC + (size_t)(t0 - 1) * 512 + c0);
            g2[0] = bflo(a2.x); g2[1] = bfhi(a2.x); g2[2] = bflo(a2.y); g2[3] = bfhi(a2.y); g2[4] = bflo(a2.z); g2[5] = bfhi(a2.z); g2[6] = bflo(a2.w); g2[7] = bfhi(a2.w);
            g1[0] = bflo(a1.x); g1[1] = bfhi(a1.x); g1[2] = bflo(a1.y); g1[3] = bfhi(a1.y); g1[4] = bflo(a1.z); g1[5] = bfhi(a1.z); g1[6] = bflo(a1.w); g1[7] = bfhi(a1.w); }
        for (int i = 0; i < 16; ++i) { const int t = t0 + i;
            const v4u ag = __builtin_nontemporal_load((const GAS v4u*)(GC + (size_t)t * 512 + c0)), ab = __builtin_nontemporal_load((const GAS v4u*)(CB + (size_t)t * 512 + c0));
            float g0[8], cb[8], cv[8];
            g0[0] = bflo(ag.x); g0[1] = bfhi(ag.x); g0[2] = bflo(ag.y); g0[3] = bfhi(ag.y); g0[4] = bflo(ag.z); g0[5] = bfhi(ag.z); g0[6] = bflo(ag.w); g0[7] = bfhi(ag.w);
            cb[0] = bflo(ab.x); cb[1] = bfhi(ab.x); cb[2] = bflo(ab.y); cb[3] = bfhi(ab.y); cb[4] = bflo(ab.z); cb[5] = bfhi(ab.z); cb[6] = bflo(ab.w); cb[7] = bfhi(ab.w);
            float s = 0.f;
#pragma unroll
            for (int k = 0; k < 8; ++k) { cv[k] = cb[k] * (w0[k] * g2[k] + w1[k] * g1[k] + w2[k] * g0[k]); s += cv[k] * cv[k]; g2[k] = g1[k]; g1[k] = g0[k]; }
            s = wave_sum(s);
            const float r = 1.f / sqrtf(s * (1.f / 512.f) + EPS);
            v4u o; o.x = pk2(cv[0] * r * gn[0], cv[1] * r * gn[1]); o.y = pk2(cv[2] * r * gn[2], cv[3] * r * gn[3]); o.z = pk2(cv[4] * r * gn[4], cv[5] * r * gn[5]); o.w = pk2(cv[6] * r * gn[6], cv[7] * r * gn[7]);
            *(GAS v4u*)(MIX + (size_t)t * 1024 + 512 + c0) = o; }
    }
}

#define SORT16_NET(CE) CE(0,1) CE(2,3) CE(0,2) CE(1,3) CE(1,2) CE(4,5) CE(6,7) CE(4,6) CE(5,7) CE(5,6) CE(0,4) CE(2,6) CE(2,4) CE(1,5) CE(3,7) CE(3,5) CE(1,2) CE(3,4) CE(5,6) CE(8,9) CE(10,11) CE(8,10) CE(9,11) CE(9,10) CE(12,13) CE(14,15) CE(12,14) CE(13,15) CE(13,14) CE(8,12) CE(10,14) CE(10,12) CE(9,13) CE(11,15) CE(11,13) CE(9,10) CE(11,12) CE(13,14) CE(0,8) CE(4,12) CE(4,8) CE(2,10) CE(6,14) CE(6,10) CE(2,4) CE(6,8) CE(10,12) CE(1,9) CE(5,13) CE(5,9) CE(3,11) CE(7,15) CE(7,11) CE(3,5) CE(7,9) CE(11,13) CE(1,2) CE(3,4) CE(5,6) CE(7,8) CE(9,10) CE(11,12) CE(13,14)
#define BITONIC16_NET(CE) CE(0,8) CE(1,9) CE(2,10) CE(3,11) CE(4,12) CE(5,13) CE(6,14) CE(7,15) CE(0,4) CE(1,5) CE(2,6) CE(3,7) CE(8,12) CE(9,13) CE(10,14) CE(11,15) CE(0,2) CE(1,3) CE(4,6) CE(5,7) CE(8,10) CE(9,11) CE(12,14) CE(13,15) CE(0,1) CE(2,3) CE(4,5) CE(6,7) CE(8,9) CE(10,11) CE(12,13) CE(14,15)

__device__ __forceinline__ void ce_desc(unsigned& a, unsigned& b) { const unsigned hi = a > b ? a : b, lo = a > b ? b : a; a = hi; b = lo; }
__device__ __forceinline__ void phase7(const Frame& F, const Args& a) {
    const unsigned* SC = (const unsigned*)(a.ws + WS_SC); int* IDX = (int*)(a.ws + WS_IDX); float* GWT = (float*)(a.ws + WS_GW);
    LAS unsigned* stg = (LAS unsigned*)(F.lds + F.wave * 16384);
    LAS unsigned* lst0 = (LAS unsigned*)(F.lds + F.wave * 16384 + 8448);
    const int lane = F.lane;
    const float* pu = a.in[17]; const float* pv = a.in[18]; unsigned char* U8 = a.ws + WS_U8; unsigned char* V8 = a.ws + WS_V8; int urow = F.gw;
    for (int it = F.gw; it < T * 16 / 128; it += F.NGW) {
        const size_t vb = (size_t)it * 128;
#pragma unroll 1
        for (int rnd = 0; rnd < 2; ++rnd) {
            unsigned R[16];
#pragma unroll 1
            for (int cch = 0; cch < 2; ++cch) {
                f32x4 ux[4], vx[4]; const bool uok = urow < NEXP;
                if (uok) {
#pragma unroll
                    for (int q = 0; q < 4; ++q) { ux[q] = __builtin_nontemporal_load((const GAS f32x4*)(pu + (size_t)urow * 1024 + 256 * q + 4 * lane)); vx[q] = __builtin_nontemporal_load((const GAS f32x4*)(pv + (size_t)urow * 1024 + 256 * q + 4 * lane)); } }
#pragma unroll 8
                for (int i = 0; i < 32; ++i) { const int row = 2 * i + (lane >> 5); stg[row * 33 + (lane & 31)] = __builtin_nontemporal_load(SC + (vb + rnd * 64 + row) * 64 + cch * 32 + (lane & 31)); }
                LDS_WAIT(); asm volatile("" ::: "memory");
#pragma unroll
                for (int hf = 0; hf < 4; ++hf) {
                    unsigned G[16];
#pragma unroll
                    for (int k = 0; k < 8; ++k) { const unsigned w = stg[lane * 33 + hf * 8 + k]; const unsigned i0 = 127u - (unsigned)(cch * 64 + hf * 16 + 2 * k);
                        G[2 * k] = (w << 16) ^ (0x80000000u | i0); G[2 * k + 1] = (w & 0xFFFF0000u) ^ (0x80000000u | (i0 - 1u)); }
#define CEG(x, y) ce_desc(G[x], G[y]);
                    SORT16_NET(CEG)
#undef CEG
                    if (cch == 0 && hf == 0) {
#pragma unroll
                        for (int k = 0; k < 16; ++k) R[k] = G[k]; }
                    else {
#pragma unroll
                        for (int k = 0; k < 16; ++k) R[k] = R[k] > G[15 - k] ? R[k] : G[15 - k];
#define CER(x, y) ce_desc(R[x], R[y]);
                        BITONIC16_NET(CER)
#undef CER
                    }
                }
                LDS_WAIT(); asm volatile("" ::: "memory");
                if (uok) {
#pragma unroll
                    for (int q = 0; q < 4; ++q) { tab_store_i8(U8, urow, q, lane, ux[q] * USCALE); tab_store_i8(V8, urow, q, lane, vx[q] * VSCALE); } }
                urow += F.NGW;
            }
            LAS unsigned* dst = rnd == 0 ? lst0 : stg;
#pragma unroll
            for (int k = 0; k < 16; ++k) dst[lane * 17 + k] = R[k];
        }
        LDS_WAIT(); asm volatile("" ::: "memory");
        const LAS unsigned* my = ((lane < 32) ? lst0 : stg) + (2 * (lane & 31)) * 17;
        int s0[16], s1[16];
#pragma unroll
        for (int i = 0; i < 16; ++i) { s0[i] = (int)(my[i] >> 16); s1[i] = (int)(my[17 + i] >> 16); }
        unsigned M[16];
#pragma unroll
        for (int j = 0; j < 16; ++j) M[j] = 0u;
#pragma unroll
        for (int i = 0; i < 16; ++i)
#pragma unroll
            for (int j = 0; j < 16; ++j) if ((i + 1) * (j + 1) <= 16) {
                unsigned key = ((unsigned)(s0[i] + s1[j]) << 8) | (unsigned)(255 - (i * 16 + j));
#pragma unroll
                for (int q = 0; q < 16; ++q) ce_desc(M[q], key);
            }
        float bv[16]; int ev[16];
#pragma unroll
        for (int q = 0; q < 16; ++q) { const unsigned ij = 255u - (M[q] & 255u); const unsigned ka = my[ij >> 4], kb = my[17 + (ij & 15u)];
            bv[q] = (float)((int)(M[q] >> 8) - (int)(M[0] >> 8)) * (1.f / 2048.f);
            ev[q] = (int)((127u - (ka & 127u)) * 128u + (127u - (kb & 127u))); }
        float sum = 0.f;
#pragma unroll
        for (int q = 0; q < 16; ++q) { bv[q] = expf(bv[q]); sum += bv[q]; }
        const float inv = 1.f / sum;
        const size_t id = vb / 2 + lane;
        GAS v4u* oi = (GAS v4u*)(IDX + id * 8); GAS f32x4* og = (GAS f32x4*)(GWT + id * 16);
#pragma unroll
        for (int q = 0; q < 2; ++q) oi[q] = (v4u){(unsigned)ev[8 * q] | ((unsigned)ev[8 * q + 1] << 16), (unsigned)ev[8 * q + 2] | ((unsigned)ev[8 * q + 3] << 16),
                                                  (unsigned)ev[8 * q + 4] | ((unsigned)ev[8 * q + 5] << 16), (unsigned)ev[8 * q + 6] | ((unsigned)ev[8 * q + 7] << 16)};
#pragma unroll
        for (int q = 0; q < 4; ++q) og[q] = (f32x4){bv[4 * q] * inv, bv[4 * q + 1] * inv, bv[4 * q + 2] * inv, bv[4 * q + 3] * inv};
        LDS_WAIT(); asm volatile("" ::: "memory");
    }
    for (; urow < NEXP; urow += F.NGW) {
#pragma unroll
        for (int q = 0; q < 4; ++q) { tab_store_i8(U8, urow, q, lane, __builtin_nontemporal_load((const GAS f32x4*)(pu + (size_t)urow * 1024 + 256 * q + 4 * lane)) * USCALE);
            tab_store_i8(V8, urow, q, lane, __builtin_nontemporal_load((const GAS f32x4*)(pv + (size_t)urow * 1024 + 256 * q + 4 * lane)) * VSCALE); } }
}

__device__ __forceinline__ float gelu_erf(float v) { return 0.5f * v * (1.f + erff(v * 0.70710678118654752f)); }
__device__ __forceinline__ int sliced_vb(const Frame& F, const Args& a) {
    const gu32* cnt = (const gu32*)(a.ws + WS_CTL) + CW_XRANK; bool ok = (F.G == 256);
#pragma unroll
    for (int x = 0; x < 8; ++x) ok = ok && (__hip_atomic_load(cnt + 64 * x, __ATOMIC_RELAXED, __HIP_MEMORY_SCOPE_AGENT) == 32u);
    return ok ? (F.xrank * 8 + F.xcc) : (int)blockIdx.x;
}
typedef float f32x2v __attribute__((ext_vector_type(2)));
#define PEER_SWZ8(SW, W) do { SW[0] = (unsigned)__builtin_amdgcn_ds_swizzle((int)(W), 0x18 | (0 << 5)); SW[1] = (unsigned)__builtin_amdgcn_ds_swizzle((int)(W), 0x18 | (1 << 5)); \
    SW[2] = (unsigned)__builtin_amdgcn_ds_swizzle((int)(W), 0x18 | (2 << 5)); SW[3] = (unsigned)__builtin_amdgcn_ds_swizzle((int)(W), 0x18 | (3 << 5)); \
    SW[4] = (unsigned)__builtin_amdgcn_ds_swizzle((int)(W), 0x18 | (4 << 5)); SW[5] = (unsigned)__builtin_amdgcn_ds_swizzle((int)(W), 0x18 | (5 << 5)); \
    SW[6] = (unsigned)__builtin_amdgcn_ds_swizzle((int)(W), 0x18 | (6 << 5)); SW[7] = (unsigned)__builtin_amdgcn_ds_swizzle((int)(W), 0x18 | (7 << 5)); } while (0)
#define PEER_GATHER(Q, BASE, COFF, SW) do { _Pragma("unroll") for (int j_ = 0; j_ < 8; ++j_) { \
    Q[2 * j_] = *(const GAS v4u*)((BASE) + (((SW[j_] << 7) & 0x7fff80u) | (COFF))); Q[2 * j_ + 1] = *(const GAS v4u*)((BASE) + (((SW[j_] >> 9) & 0x7fff80u) | (COFF))); } } while (0)
__device__ __forceinline__ void treduce16i_dpp210(const int (&d)[16], int lane, int& r0, int& r1) {
    const bool b2 = (lane >> 2) & 1, b1 = (lane >> 1) & 1, b0 = lane & 1;
    int e[8], f[4];
#pragma unroll
    for (int k = 0; k < 8; ++k) { const int mine = b2 ? d[k + 8] : d[k], theirs = b2 ? d[k] : d[k + 8]; e[k] = mine + __builtin_amdgcn_update_dpp(0, theirs, 0x141, 0xf, 0xf, false); }
#pragma unroll
    for (int k = 0; k < 4; ++k) { const int mine = b1 ? e[k + 4] : e[k], theirs = b1 ? e[k] : e[k + 4]; f[k] = mine + __builtin_amdgcn_update_dpp(0, theirs, 0x4E, 0xf, 0xf, false); }
    { const int m0 = b0 ? f[2] : f[0], t0 = b0 ? f[0] : f[2]; r0 = m0 + __builtin_amdgcn_update_dpp(0, t0, 0xB1, 0xf, 0xf, false);
      const int m1 = b0 ? f[3] : f[1], t1 = b0 ? f[1] : f[3]; r1 = m1 + __builtin_amdgcn_update_dpp(0, t1, 0xB1, 0xf, 0xf, false); }
}
__device__ __forceinline__ void treduce16i_swap543(const int (&d)[16], int lane, int& r0, int& r1) {
    const bool b0 = (lane >> 3) & 1;
    int e[8], f[4];
#pragma unroll
    for (int k = 0; k < 8; ++k) { const auto s = __builtin_amdgcn_permlane32_swap((unsigned)d[k], (unsigned)d[k + 8], false, false); e[k] = (int)(s[0] + s[1]); }
#pragma unroll
    for (int k = 0; k < 4; ++k) { const auto s = __builtin_amdgcn_permlane16_swap((unsigned)e[k], (unsigned)e[k + 4], false, false); f[k] = (int)(s[0] + s[1]); }
    { const int m0 = b0 ? f[2] : f[0], t0 = b0 ? f[0] : f[2]; r0 = m0 + __builtin_amdgcn_update_dpp(0, t0, 0x128, 0xf, 0xf, false);
      const int m1 = b0 ? f[3] : f[1], t1 = b0 ? f[1] : f[3]; r1 = m1 + __builtin_amdgcn_update_dpp(0, t1, 0x128, 0xf, 0xf, false); }
}
__device__ __forceinline__ int dot16_i8(const v4u& q, const v4u& h) {
    int s = __builtin_amdgcn_sdot4((int)q.x, (int)h.x, 0, false); s = __builtin_amdgcn_sdot4((int)q.y, (int)h.y, s, false);
    s = __builtin_amdgcn_sdot4((int)q.z, (int)h.z, s, false); return __builtin_amdgcn_sdot4((int)q.w, (int)h.w, s, false);
}
__device__ __forceinline__ void phase8(const Frame& F, const Args& a) {
    unsigned char* ws = a.ws;
    const unsigned char* H8 = ws + WS_H8; const float* HS = (const float*)(ws + WS_HS); const unsigned char* U8 = ws + WS_U8; const int* IDX = (const int*)(ws + WS_IDX); bf16* PART = (bf16*)(ws + WS_PART);
    const int lane = F.lane, g = lane >> 3, c = lane & 7;
    for (int vb = __builtin_amdgcn_readfirstlane(sliced_vb(F, a)); vb < 256; vb += F.G) {
        const int slice = vb & 7, tbase = (vb >> 3) * 1024 + F.wave * 128;
        const unsigned char* Us = U8 + (size_t)slice * ((size_t)NEXP * 128); const unsigned coff = (unsigned)c * 16u;
        const GAS unsigned* ipb = (const GAS unsigned*)IDX + (size_t)tbase * 64 + lane;
        const GAS unsigned* hpb = (const GAS unsigned*)(H8 + (size_t)tbase * 1024 + slice * 128) + (4 * c + (g & 3));
        bf16* pout = PART + ((size_t)slice * T + tbase) * 128 + 16 * g + 2 * c;
        v4u qA[16], qB[16], hsA, hsB; unsigned sw[8];
#define P8_SWZ(W, J) ((unsigned)__builtin_amdgcn_ds_swizzle((int)(W), 0x07 | ((J) << 8)))
#define P8_HSWZ(HS_, HW) do { HS_ = (v4u){P8_SWZ(HW, 0), P8_SWZ(HW, 1), P8_SWZ(HW, 2), P8_SWZ(HW, 3)}; } while (0)
#define P8_MATH(Q, HV, TI) do { int d[16]; _Pragma("unroll") for (int k = 0; k < 16; ++k) d[k] = dot16_i8(Q[k], HV); \
            int r0, r1; treduce16i_dpp210(d, lane, r0, r1); \
            *(GAS unsigned*)(pout + (size_t)(TI) * 128) = pk2((float)r0, (float)r1); } while (0)
#define P8_TOK(X) ((X) < 127 ? (X) : 127)
        unsigned iw = ipb[0], hw = hpb[0];
        PEER_SWZ8(sw, iw); P8_HSWZ(hsA, hw); PEER_GATHER(qA, Us, coff, sw);
        iw = ipb[64]; hw = hpb[256];
        PEER_SWZ8(sw, iw); P8_HSWZ(hsB, hw);
        iw = ipb[2 * 64]; hw = hpb[2 * 256];
#pragma unroll 1
        for (int i = 0; i < 126; i += 2) {
            PEER_GATHER(qB, Us, coff, sw);
            PEER_SWZ8(sw, iw); iw = ipb[P8_TOK(i + 3) * 64];
            P8_MATH(qA, hsA, i);
            P8_HSWZ(hsA, hw); hw = hpb[P8_TOK(i + 3) * 256];
            PEER_GATHER(qA, Us, coff, sw);
            PEER_SWZ8(sw, iw); iw = ipb[P8_TOK(i + 4) * 64];
            P8_MATH(qB, hsB, i + 1);
            P8_HSWZ(hsB, hw); hw = hpb[P8_TOK(i + 4) * 256];
        }
        PEER_GATHER(qB, Us, coff, sw);
        P8_MATH(qA, hsA, 126);
        P8_MATH(qB, hsB, 127);
#undef P8_HSWZ
#undef P8_TOK
#undef P8_MATH
    }
}
__device__ __forceinline__ void phase9(const Frame& F, const Args& a) {
    unsigned char* ws = a.ws;
    const bf16* PART = (const bf16*)(ws + WS_PART); const float* GWT = (const float*)(ws + WS_GW); unsigned char* W8 = ws + WS_W; float* WSC = (float*)(ws + WS_WSC); const float* HS = (const float*)(ws + WS_HS);
    const size_t n8 = (size_t)T * 128 / 8;
    for (size_t i = (size_t)F.vcu * 512 + F.tid; i < n8; i += (size_t)F.G * 512) {
        float s[8];
#pragma unroll
        for (int k = 0; k < 8; ++k) s[k] = 0.f;
#pragma unroll
        for (int x = 0; x < 8; ++x) { const v4u q = __builtin_nontemporal_load((const GAS v4u*)(PART + (size_t)x * T * 128 + i * 8));
            s[0] += bflo(q.x); s[1] += bfhi(q.x); s[2] += bflo(q.y); s[3] += bfhi(q.y); s[4] += bflo(q.z); s[5] += bfhi(q.z); s[6] += bflo(q.w); s[7] += bfhi(q.w); }
        const f32x4 g0 = __builtin_nontemporal_load((const GAS f32x4*)(GWT + i * 8)), g1 = __builtin_nontemporal_load((const GAS f32x4*)(GWT + i * 8 + 4));
        { const float hs_ = HS[i >> 4] * (1.f / USCALE);
#pragma unroll
          for (int k = 0; k < 8; ++k) s[k] *= hs_; }
        float o[8]; float mx = 0.f;
#pragma unroll
        for (int k = 0; k < 4; ++k) { o[k] = g0[k] * gelu_erf(s[k]); o[4 + k] = g1[k] * gelu_erf(s[4 + k]); }
#pragma unroll
        for (int k = 0; k < 8; ++k) mx = fmaxf(mx, fabsf(o[k]));
        mx = row16_max(mx);
        mx = fmaxf(mx, 1e-30f); const float inv = 127.f / mx;
        unsigned w0 = 0u, w1 = 0u;
#pragma unroll
        for (int k = 0; k < 4; ++k) { w0 |= ((unsigned)(int)__builtin_rintf(o[k] * inv) & 0xffu) << (8 * k); w1 |= ((unsigned)(int)__builtin_rintf(o[4 + k] * inv) & 0xffu) << (8 * k); }
        typedef unsigned u32x2v __attribute__((ext_vector_type(2)));
        *(GAS u32x2v*)(W8 + i * 8) = (u32x2v){w0, w1};
        if ((F.lane & 15) == 0) WSC[i >> 4] = mx * (1.f / 127.f);
    }
}
__device__ __forceinline__ void tr4x4(unsigned a, unsigned b, unsigned c, unsigned d, unsigned (&o)[4]) {
    const unsigned x0 = __builtin_amdgcn_perm(b, a, 0x05010400u), x1 = __builtin_amdgcn_perm(b, a, 0x07030602u);
    const unsigned y0 = __builtin_amdgcn_perm(d, c, 0x05010400u), y1 = __builtin_amdgcn_perm(d, c, 0x07030602u);
    o[0] = __builtin_amdgcn_perm(y0, x0, 0x05040100u); o[1] = __builtin_amdgcn_perm(y0, x0, 0x07060302u);
    o[2] = __builtin_amdgcn_perm(y1, x1, 0x05040100u); o[3] = __builtin_amdgcn_perm(y1, x1, 0x07060302u);
}
__device__ __forceinline__ void phase10(const Frame& F, const Args& a) {
    unsigned char* ws = a.ws;
    const unsigned char* V8 = ws + WS_V8; const int* IDX = (const int*)(ws + WS_IDX); const unsigned char* W8 = ws + WS_W; const float* WSC = (const float*)(ws + WS_WSC);
    bf16* Y = (bf16*)(ws + WS_Y);
    const int lane = F.lane, g = lane >> 3, c = lane & 7;
    for (int vb = __builtin_amdgcn_readfirstlane(sliced_vb(F, a)); vb < 256; vb += F.G) {
        const int slice = vb & 7, tbase = (vb >> 3) * 1024 + F.wave * 128;
        const unsigned char* Vs = V8 + (size_t)slice * ((size_t)NEXP * 128); const unsigned coff = (unsigned)c * 16u;
        const GAS unsigned* ipb = (const GAS unsigned*)IDX + (size_t)tbase * 64 + lane;
        const GAS unsigned* wpb = (const GAS unsigned*)(W8 + (size_t)tbase * 128) + (4 * g + (c & 3));
        const int col = slice * 128 + 16 * c + 2 * g;
        GAS unsigned* ypb = (GAS unsigned*)(Y + (size_t)tbase * 1024 + col);
        v4u qA[16], qB[16], wsA, wsB; unsigned sw[8];
#define P10_RG(Q, RG, WQ) do { unsigned t_[4]; \
            tr4x4(Q[4 * RG].x, Q[4 * RG + 1].x, Q[4 * RG + 2].x, Q[4 * RG + 3].x, t_); _Pragma("unroll") for (int j = 0; j < 4; ++j) d[j] = __builtin_amdgcn_sdot4((int)t_[j], (int)(WQ), d[j], false); \
            tr4x4(Q[4 * RG].y, Q[4 * RG + 1].y, Q[4 * RG + 2].y, Q[4 * RG + 3].y, t_); _Pragma("unroll") for (int j = 0; j < 4; ++j) d[4 + j] = __builtin_amdgcn_sdot4((int)t_[j], (int)(WQ), d[4 + j], false); \
            tr4x4(Q[4 * RG].z, Q[4 * RG + 1].z, Q[4 * RG + 2].z, Q[4 * RG + 3].z, t_); _Pragma("unroll") for (int j = 0; j < 4; ++j) d[8 + j] = __builtin_amdgcn_sdot4((int)t_[j], (int)(WQ), d[8 + j], false); \
            tr4x4(Q[4 * RG].w, Q[4 * RG + 1].w, Q[4 * RG + 2].w, Q[4 * RG + 3].w, t_); _Pragma("unroll") for (int j = 0; j < 4; ++j) d[12 + j] = __builtin_amdgcn_sdot4((int)t_[j], (int)(WQ), d[12 + j], false); } while (0)
#define P10_SWZ(W, J) ((unsigned)__builtin_amdgcn_ds_swizzle((int)(W), 0x18 | ((J) << 5)))
#define P10_WSWZ(WS_, WW) do { WS_ = (v4u){P10_SWZ(WW, 0), P10_SWZ(WW, 1), P10_SWZ(WW, 2), P10_SWZ(WW, 3)}; } while (0)
#define P10_MATH(Q, WV, TI) do { int d[16]; _Pragma("unroll") for (int k = 0; k < 16; ++k) d[k] = 0; \
            P10_RG(Q, 0, WV.x); P10_RG(Q, 1, WV.y); P10_RG(Q, 2, WV.z); P10_RG(Q, 3, WV.w); \
            int r0, r1; treduce16i_swap543(d, lane, r0, r1); \
            ypb[(size_t)(TI) * 512] = pk2((float)r0, (float)r1); } while (0)
#define P10_TOK(X) ((X) < 127 ? (X) : 127)
        unsigned iw = ipb[0], ww = wpb[0];
        PEER_SWZ8(sw, iw); P10_WSWZ(wsA, ww); PEER_GATHER(qA, Vs, coff, sw);
        iw = ipb[64]; ww = wpb[32];
        PEER_SWZ8(sw, iw); P10_WSWZ(wsB, ww);
        iw = ipb[2 * 64]; ww = wpb[2 * 32];
#pragma unroll 1
        for (int i = 0; i < 126; i += 2) {
            PEER_GATHER(qB, Vs, coff, sw);
            PEER_SWZ8(sw, iw); iw = ipb[P10_TOK(i + 3) * 64];
            P10_MATH(qA, wsA, i);
            P10_WSWZ(wsA, ww); ww = wpb[P10_TOK(i + 3) * 32];
            PEER_GATHER(qA, Vs, coff, sw);
            PEER_SWZ8(sw, iw); iw = ipb[P10_TOK(i + 4) * 64];
            P10_MATH(qB, wsB, i + 1);
            P10_WSWZ(wsB, ww); ww = wpb[P10_TOK(i + 4) * 32];
        }
        PEER_GATHER(qB, Vs, coff, sw);
        P10_MATH(qA, wsA, 126);
        P10_MATH(qB, wsB, 127);
#undef P10_WSWZ
#undef P10_TOK
#undef P10_RG
#undef P10_MATH
    }
}
__device__ __forceinline__ void phase11(const Frame& F, const Args& a) {
    const bf16* Y = (const bf16*)(a.ws + WS_Y); const bf16* X1 = (const bf16*)(a.ws + WS_H); const float* MOD = (const float*)(a.ws + WS_MOD); const float* WSC = (const float*)(a.ws + WS_WSC); float* O = a.out; const float* fg = a.in[19];
    f32x4 fgv[4];
#pragma unroll
    for (int j = 0; j < 4; ++j) fgv[j] = *(const f32x4*)(fg + 4 * F.lane + 256 * j);
    for (int t = F.gw; t < T; t += F.NGW) {
        const GAS unsigned long long* yr = (const GAS unsigned long long*)(Y + (size_t)t * 1024) + F.lane;
        const GAS unsigned long long* dr = (const GAS unsigned long long*)(X1 + (size_t)t * 1024) + F.lane;
        const float* g2p = MOD + (size_t)(t >> 11) * 6144 + 5120 + 4 * F.lane; const float ysc = WSC[t] * (1.f / VSCALE);
        f32x4 v[4]; float ss = 0.f;
#pragma unroll
        for (int j = 0; j < 4; ++j) { const unsigned long long yy = __builtin_nontemporal_load(yr + 64 * j), dd = __builtin_nontemporal_load(dr + 64 * j); const f32x4 gg = *(const f32x4*)(g2p + 256 * j) * ysc;
            const unsigned ylo = (unsigned)yy, yhi = (unsigned)(yy >> 32), dlo = (unsigned)dd, dhi = (unsigned)(dd >> 32);
            v[j] = (f32x4){bflo(dlo) + gg[0] * bflo(ylo), bfhi(dlo) + gg[1] * bfhi(ylo), bflo(dhi) + gg[2] * bflo(yhi), bfhi(dhi) + gg[3] * bfhi(yhi)};
            ss += (v[j][0] * v[j][0] + v[j][1] * v[j][1]) + (v[j][2] * v[j][2] + v[j][3] * v[j][3]); }
        ss = wave_sum(ss);
        const float r = 1.f / sqrtf(ss * (1.f / 1024.f) + EPS);
        GAS f32x4* orow = (GAS f32x4*)(O + (size_t)t * 1024) + F.lane;
#pragma unroll
        for (int j = 0; j < 4; ++j) __builtin_nontemporal_store(v[j] * r * fgv[j], orow + 64 * j);
    }
}
__global__ void __launch_bounds__(NWAVES * 64, 2) mk_fwd(Args args) {
    extern __shared__ __attribute__((aligned(16))) unsigned char lds[];
    Frame F;
    F.lds = (LAS unsigned char*)lds; F.ldsg = lds;
    F.tid = threadIdx.x; F.lane = F.tid & 63; F.wave = __builtin_amdgcn_readfirstlane(F.tid >> 6);
    F.G = gridDim.x; { const int bx = blockIdx.x; F.vcu = (F.G % 8 == 0) ? (bx % 8) * (F.G / 8) + bx / 8 : bx; }
    F.gw = F.vcu * NWAVES + F.wave; F.NGW = F.G * NWAVES;
    volatile LAS unsigned* MISC = (volatile LAS unsigned*)(F.lds + MISC_OFF);
    unsigned char* ws = args.ws;
    gu32* ctl = (gu32*)(ws + WS_CTL);
    for (int u = F.tid; u < (LDS_BYTES - LDSCTL_OFF) / 4; u += NWAVES * 64) ((LAS unsigned*)(F.lds + LDSCTL_OFF))[u] = 0u;
    __syncthreads();
    const int lo = args.ph_lo, hi = args.ph_hi;
    if (F.tid == 0) { const unsigned x = xb_xcc_id() & 7u; MISC[16] = x; MISC[17] = __hip_atomic_fetch_add((unsigned*)(ctl + CW_XRANK) + 64 * x, 1u, __ATOMIC_RELAXED, __HIP_MEMORY_SCOPE_AGENT); }
    __syncthreads();
    F.xcc = (int)MISC[16]; F.xrank = (int)MISC[17];
    XcdBarrier bar; bar.bar = (unsigned*)(ctl + CW_BAR) + args.li * XCD_BAR_WORDS; bar.x = 0; bar.st = nullptr;
    if (hi - lo > 1) bar = xcd_barrier_post((unsigned*)(ctl + CW_BAR) + args.li * XCD_BAR_WORDS, MISC + 8);
#ifndef PHASE_MASK
#define PHASE_MASK 0xfff
#endif
#define IN(k) (((PHASE_MASK >> (k)) & 1) && lo <= (k) && (k) < hi)
#define SEAM(k) do { if (IN(k) && IN((k) + 1)) xcd_barrier(bar); } while (0)
#ifndef REP_MASK
#define REP_MASK 0
#endif
#ifndef GREP1
#define GREP1 1
#endif
#ifndef GREP2
#define GREP2 1
#endif
#ifndef GREP3
#define GREP3 1
#endif
#define NREP(k) (((REP_MASK >> (k)) & 1) ? 2 : 1)

#ifdef EXTRA_BARRIERS
    if (hi - lo > 1) for (int xb_ = 0; xb_ < EXTRA_BARRIERS; ++xb_) xcd_barrier(bar);
#endif
    if (IN(0)) for (int rep_ = 0; rep_ < NREP(0); ++rep_) { phase0(F, args); } SEAM(0);
    if (IN(1)) for (int rep_ = 0; rep_ < NREP(1); ++rep_) { __syncthreads(); phase1(F, args); } SEAM(1);
    if (IN(2)) for (int rep_ = 0; rep_ < NREP(2); ++rep_) { __syncthreads();
        pg8::Gemm g{(const pg8::bf16_t*)(ws + WS_H8), (const pg8::bf16_t*)(ws + WS_WIN), T, IN_COLS, DM / 2}; pg8::StaticOrder S; S.init(T, IN_COLS, F.G, (int)blockIdx.x, GREP1);
        pg8::EpiPI E{(pg8::bf16_t*)(ws + WS_Q), (pg8::bf16_t*)(ws + WS_K), (pg8::bf16_t*)(ws + WS_VV), (pg8::bf16_t*)(ws + WS_CB), (pg8::bf16_t*)(ws + WS_GC), 0.125f * 1.4426950408889634f, (const float*)(ws + WS_HS), (const float*)(ws + WS_WINS)};
        pg8::gemm_phase<pg8::EpiPI, pg8::StaticOrder, true, true, true>(F.lds, g, S, E); } SEAM(2);
    if (IN(3)) for (int rep_ = 0; rep_ < NREP(3); ++rep_) { __syncthreads(); phase3(F, args); } SEAM(3);
    if (IN(4)) for (int rep_ = 0; rep_ < NREP(4); ++rep_) { __syncthreads();
        pg8::Gemm g{(const pg8::bf16_t*)(ws + WS_MIX), (const pg8::bf16_t*)(ws + WS_WO), T, DM, DM}; pg8::StaticOrder S; S.init(T, DM, F.G, (int)blockIdx.x, GREP2);
        pg8::EpiGate E{(pg8::bf16_t*)(ws + WS_DELTA), (const float*)(ws + WS_MOD)};
        pg8::gemm_phase<pg8::EpiGate, pg8::StaticOrder, true, true>(F.lds, g, S, E); } SEAM(4);
    if (IN(5)) for (int rep_ = 0; rep_ < NREP(5); ++rep_) { __syncthreads(); norm_rows<false, true, true>(F, args.in[0], (const bf16*)(ws + WS_DELTA), (bf16*)(ws + WS_H), (unsigned*)(ws + WS_H8), (float*)(ws + WS_HS), args.in[14], (const float*)(ws + WS_MOD), nullptr, 3072, 4096); } SEAM(5);
    if (IN(6)) for (int rep_ = 0; rep_ < NREP(6); ++rep_) { __syncthreads();
        pg8::Gemm g{(const pg8::bf16_t*)(ws + WS_H8), (const pg8::bf16_t*)(ws + WS_WK), T, 2048, DM / 2}; pg8::StaticOrder S; S.init(T, 2048, F.G, (int)blockIdx.x, GREP3);
        pg8::EpiS16I E{(short*)(ws + WS_SC), 2048, (const float*)(ws + WS_HS), (const float*)(ws + WS_WKS)};
        pg8::gemm_phase<pg8::EpiS16I, pg8::StaticOrder, true, true, true>(F.lds, g, S, E); } SEAM(6);
    if (IN(7)) for (int rep_ = 0; rep_ < NREP(7); ++rep_) { __syncthreads(); phase7(F, args); } SEAM(7);
    if (IN(8)) for (int rep_ = 0; rep_ < NREP(8); ++rep_) { __syncthreads(); phase8(F, args); } SEAM(8);
    if (IN(9)) for (int rep_ = 0; rep_ < NREP(9); ++rep_) { __syncthreads(); phase9(F, args); } SEAM(9);
    if (IN(10)) for (int rep_ = 0; rep_ < NREP(10); ++rep_) { __syncthreads(); phase10(F, args); } SEAM(10);
    if (IN(11)) for (int rep_ = 0; rep_ < NREP(11); ++rep_) { __syncthreads(); phase11(F, args); }
#undef IN
#undef SEAM
}

extern "C" void kernel_launch(void* const* d_in, const int* in_sizes, int n_in, void* d_out, int out_size, void* d_ws, size_t ws_size, hipStream_t stream) {
    static int grid = 0;
    if (grid == 0) {
        if (n_in != 20 || in_sizes[0] != T * DM || out_size != T * DM || ws_size < WS_END) {
            fprintf(stderr, "kernel_launch: built for 20 inputs, x/out of %d floats, >= %zu bytes of workspace; got n_in %d, in0 %d, out %d, ws %zu; nothing launched\n", T * DM, (size_t)WS_END, n_in, n_in > 0 ? in_sizes[0] : -1, out_size, ws_size);
            grid = -1; return; }
        int dev = 0, cus = 0, per_cu = 0;
        if (hipGetDevice(&dev) != hipSuccess || hipDeviceGetAttribute(&cus, hipDeviceAttributeMultiprocessorCount, dev) != hipSuccess) { fprintf(stderr, "kernel_launch: device query failed\n"); grid = -1; return; }
        if (hipFuncSetAttribute((const void*)mk_fwd, hipFuncAttributeMaxDynamicSharedMemorySize, LDS_BYTES) != hipSuccess) { fprintf(stderr, "kernel_launch: hipFuncSetAttribute failed\n"); grid = -1; return; }
        if (hipOccupancyMaxActiveBlocksPerMultiprocessor(&per_cu, (const void*)mk_fwd, NWAVES * 64, LDS_BYTES) != hipSuccess || per_cu < 1) {
            fprintf(stderr, "kernel_launch: occupancy query reports %d workgroups per CU; nothing launched\n", per_cu); (void)hipGetLastError(); grid = -1; return; }
        grid = cus;
    }
    if (grid < 0) return;
    if (hipMemsetAsync((char*)d_ws + WS_CTL, 0, CTL_ZERO_BYTES, stream) != hipSuccess) { fprintf(stderr, "kernel_launch: memset failed\n"); return; }
    Args a{};
    for (int i = 0; i < 20; ++i) a.in[i] = (const float*)d_in[i];
    a.out = (float*)d_out; a.ws = (unsigned char*)d_ws;
    if (N_LAUNCHES == 1) { a.ph_lo = 0; a.ph_hi = N_PHASES; a.li = 0; hipLaunchKernelGGL(mk_fwd, dim3(grid), dim3(NWAVES * 64), LDS_BYTES, stream, a); }
    else { for (int p = 0; p < N_PHASES; ++p) { a.ph_lo = p; a.ph_hi = p + 1; a.li = 0; hipLaunchKernelGGL(mk_fwd, dim3(grid), dim3(NWAVES * 64), LDS_BYTES, stream, a); } }
    const hipError_t le = hipPeekAtLastError();
    if (le != hipSuccess) fprintf(stderr, "kernel_launch: launch failed: %s\n", hipGetErrorName(le));
}
```

```cpp
#include <hip/hip_runtime.h>
#include <hip/hip_bf16.h>
#include <cstdio>
#include <cstdint>
#include <cmath>

#define REP_MASK 0
#define PG8_REPG 1
#define ATT_REP 1
#ifndef MK_N_LAUNCHES
#define MK_N_LAUNCHES 1
#endif

#ifndef PG8_REPG
#define PG8_REPG 1
#endif
namespace pg8 {
#define PG8_LAS __attribute__((address_space(3)))
typedef unsigned short bf16_t;
typedef short bf16x8 __attribute__((ext_vector_type(8)));
typedef float f32x4 __attribute__((ext_vector_type(4)));
typedef unsigned u32x4 __attribute__((ext_vector_type(4)));
constexpr int BM = 256, BK = 64, HALF = 128, HTB = HALF * BK * 2  , STAGE_BYTES = 8 * HTB, NXCD = 8, WGM = 8;

__host__ __device__ __forceinline__ int lds_byte(int r, int c) { const int st = (r >> 4) * 2 + (c >> 5), rr = r & 15, cc = c & 31, ob = rr * 64 + cc * 2; return st * 1024 + (ob ^ (((ob >> 9) & 1) << 5)); }
__host__ __device__ __forceinline__ void stage_rc(int b, int& R, int& C) { const int st = b / 1024, sb = b % 1024, swz = sb ^ (((sb >> 9) & 1) << 5); R = (st >> 1) * 16 + swz / 64; C = (st & 1) * 32 + (swz % 64) / 2; }
__host__ __device__ __forceinline__ int perm32(int rho) { const int n = rho >> 4, i = rho & 15; return 8 * (i >> 2) + 4 * n + (i & 3); }

struct Unit { int pm, pn; };
struct Gemm { const bf16_t* A; const bf16_t* Bt; int M, N, K; };

struct StaticOrder {
    int nM, nN, nwg, G, c, rep;
    __host__ __device__ void init(int M, int N, int G_, int c_, int rep_ = 1) { nM = M / BM; nN = N / BM; nwg = nM * nN; G = G_; c = c_; rep = rep_; }
    __host__ __device__ bool next(int i, Unit& u) const {
        const long L = (long)i * G + c; if (L >= (long)nwg * PG8_REPG * rep) return false;
        int wgid = (int)(L % nwg); { const int q = nwg / NXCD, r = nwg % NXCD, xcd = wgid % NXCD, off = wgid / NXCD; wgid = (xcd < r ? xcd * (q + 1) : r * (q + 1) + (xcd - r) * q) + off; }
        const int nig = WGM * nN, gid = wgid / nig, fm = gid * WGM, gsz = (nM - fm) < WGM ? (nM - fm) : WGM;
        u.pm = fm + ((wgid % nig) % gsz); u.pn = (wgid % nig) / gsz; return true;
    }
    __device__ __forceinline__ void a_ready(const Unit&) const {}
    __device__ __forceinline__ void done(const Unit&) const {}
};

__device__ __forceinline__ unsigned cvt_pk_bf16(float lo, float hi) { unsigned r; asm volatile("v_cvt_pk_bf16_f32 %0, %1, %2" : "=v"(r) : "v"(lo), "v"(hi)); return r; }
__device__ __forceinline__ void st16_wt(const void* base, size_t byte_off, u32x4 w) {
    const __amdgpu_buffer_rsrc_t r = __builtin_amdgcn_make_buffer_rsrc((void*)base, 0, 0x7fffffff, 0x00020000);
    __builtin_amdgcn_raw_buffer_store_b128(w, r, (int)byte_off, 0, 16);
}
struct EpiP {
    static constexpr bool PERM = true, AFTER_DRAIN = false;
    bf16_t *Q, *K, *V, *CB, *GC; float qscale;
    __device__ __forceinline__ static void st16(bf16_t* base, size_t elem_off, u32x4 w) { st16_wt(base, elem_off * 2, w); }
    __device__ __forceinline__ void operator()(const f32x4 (&acc)[2][2][4][2], const Unit& u, int wr, int wc, int fr, int fq) const {
        const int row0 = u.pm * BM + wr * 64 + fr;
        if (u.pn < 8) {
            const int sel = u.pn >> 1; bf16_t* base = sel == 0 ? Q : (sel == 1 ? K : (sel == 2 ? V : CB));
            const float sc = sel == 0 ? qscale : 1.f; const int col0 = (u.pn & 1) * 256 + wc * 32 + 8 * fq;
#pragma unroll
            for (int ai = 0; ai < 2; ++ai)
#pragma unroll
                for (int m = 0; m < 4; ++m) { const size_t off = (size_t)(row0 + ai * HALF + m * 16) * 512 + col0;
#pragma unroll
                    for (int bj = 0; bj < 2; ++bj) { const f32x4 v0 = acc[ai][bj][m][0] * sc, v1 = acc[ai][bj][m][1] * sc;
                        u32x4 w; w.x = cvt_pk_bf16(v0[0], v0[1]); w.y = cvt_pk_bf16(v0[2], v0[3]); w.z = cvt_pk_bf16(v1[0], v1[1]); w.w = cvt_pk_bf16(v1[2], v1[3]);
                        st16(base, off + bj * HALF, w); } }
        } else {
            const int col0 = (u.pn - 8) * 128 + wc * 32 + 8 * fq;
#pragma unroll
            for (int ai = 0; ai < 2; ++ai)
#pragma unroll
                for (int m = 0; m < 4; ++m) { const size_t off = (size_t)(row0 + ai * HALF + m * 16) * 512 + col0;
                    const f32x4 v0 = acc[ai][0][m][0] * acc[ai][1][m][0], v1 = acc[ai][0][m][1] * acc[ai][1][m][1];
                    u32x4 w; w.x = cvt_pk_bf16(v0[0], v0[1]); w.y = cvt_pk_bf16(v0[2], v0[3]); w.z = cvt_pk_bf16(v1[0], v1[1]); w.w = cvt_pk_bf16(v1[2], v1[3]);
                    st16(GC, off, w); }
        }
    }
};
struct EpiGate {
    static constexpr bool PERM = true, AFTER_DRAIN = false;
    bf16_t* O; const float* MOD;
    __device__ __forceinline__ void operator()(const f32x4 (&acc)[2][2][4][2], const Unit& u, int wr, int wc, int fr, int fq) const {
        const int row0 = u.pm * BM + wr * 64 + fr, col0 = u.pn * BM + wc * 32 + 8 * fq; const int b = u.pm >> 3;
        f32x4 gv[2][2];
#pragma unroll
        for (int bj = 0; bj < 2; ++bj)
#pragma unroll
            for (int n = 0; n < 2; ++n) gv[bj][n] = *(const f32x4*)(MOD + (size_t)b * 6144 + 2048 + col0 + bj * HALF + 4 * n);
#pragma unroll
        for (int ai = 0; ai < 2; ++ai)
#pragma unroll
            for (int m = 0; m < 4; ++m) { const size_t off = ((size_t)(row0 + ai * HALF + m * 16) * 1024 + col0) * 2;
#pragma unroll
                for (int bj = 0; bj < 2; ++bj) { const f32x4 v0 = acc[ai][bj][m][0] * gv[bj][0], v1 = acc[ai][bj][m][1] * gv[bj][1];
                    u32x4 w; w.x = cvt_pk_bf16(v0[0], v0[1]); w.y = cvt_pk_bf16(v0[2], v0[3]); w.z = cvt_pk_bf16(v1[0], v1[1]); w.w = cvt_pk_bf16(v1[2], v1[3]);
                    *(u32x4*)((char*)O + off + bj * HALF * 2) = w; } }
    }
};
typedef short s16x2 __attribute__((ext_vector_type(2)));
struct EpiS16 {
    static constexpr bool PERM = true, AFTER_DRAIN = false;
    short* C; int ldc;
    __device__ __forceinline__ static unsigned q2s(float a, float b) { const s16x2 r = __builtin_amdgcn_cvt_pk_i16((int)__builtin_rintf(a), (int)__builtin_rintf(b)); return __builtin_bit_cast(unsigned, r); }
    __device__ __forceinline__ static unsigned q2(float a, float b) { const s16x2 r = __builtin_amdgcn_cvt_pk_i16((int)__builtin_rintf(a * 2048.f), (int)__builtin_rintf(b * 2048.f)); return __builtin_bit_cast(unsigned, r); }
    __device__ __forceinline__ void operator()(const f32x4 (&acc)[2][2][4][2], const Unit& u, int wr, int wc, int fr, int fq) const {
        const int row0 = u.pm * BM + wr * 64 + fr, col0 = u.pn * BM + wc * 32 + 8 * fq;
#pragma unroll
        for (int ai = 0; ai < 2; ++ai)
#pragma unroll
            for (int m = 0; m < 4; ++m) { const size_t off = ((size_t)(row0 + ai * HALF + m * 16) * ldc + col0) * 2;
#pragma unroll
                for (int bj = 0; bj < 2; ++bj) { const f32x4 v0 = acc[ai][bj][m][0], v1 = acc[ai][bj][m][1];
                    u32x4 w; w.x = q2(v0[0], v0[1]); w.y = q2(v0[2], v0[3]); w.z = q2(v1[0], v1[1]); w.w = q2(v1[2], v1[3]);
                    *(u32x4*)((char*)C + off + bj * HALF * 2) = w; } }
    }
};

struct EpiS16I {
    static constexpr bool PERM = true, AFTER_DRAIN = false;
    short* C; int ldc; const float* HS; const float* WKS;
    __device__ __forceinline__ void operator()(const f32x4 (&acc)[2][2][4][2], const Unit& u, int wr, int wc, int fr, int fq) const {
        typedef int i32x4_t __attribute__((ext_vector_type(4)));
        const int row0 = u.pm * BM + wr * 64 + fr, col0 = u.pn * BM + wc * 32 + 8 * fq;
        f32x4 cs[2][2];
#pragma unroll
        for (int bj = 0; bj < 2; ++bj)
#pragma unroll
            for (int n = 0; n < 2; ++n) cs[bj][n] = *(const f32x4*)(WKS + col0 + bj * HALF + 4 * n) * 2048.f;
#pragma unroll
        for (int ai = 0; ai < 2; ++ai)
#pragma unroll
            for (int m = 0; m < 4; ++m) { const int row = row0 + ai * HALF + m * 16; const float rs = HS[row]; short* rowp = C + (size_t)row * ldc + col0;
#pragma unroll
                for (int bj = 0; bj < 2; ++bj) { const i32x4_t a0 = __builtin_bit_cast(i32x4_t, acc[ai][bj][m][0]), a1 = __builtin_bit_cast(i32x4_t, acc[ai][bj][m][1]);
                    const f32x4 v0 = (f32x4){(float)a0[0], (float)a0[1], (float)a0[2], (float)a0[3]} * cs[bj][0] * rs, v1 = (f32x4){(float)a1[0], (float)a1[1], (float)a1[2], (float)a1[3]} * cs[bj][1] * rs;
                    u32x4 w; w.x = EpiS16::q2s(v0[0], v0[1]); w.y = EpiS16::q2s(v0[2], v0[3]); w.z = EpiS16::q2s(v1[0], v1[1]); w.w = EpiS16::q2s(v1[2], v1[3]);
                    *(u32x4*)(rowp + bj * HALF) = w; } }
    }
};
struct EpiPI {
    static constexpr bool PERM = true, AFTER_DRAIN = false;
    bf16_t *Q, *K, *V, *CB, *GC; float qscale; const float* HS; const float* WINS; unsigned* KN;
    __device__ __forceinline__ static f32x4 cvt4(f32x4 a) { typedef int i32x4_t __attribute__((ext_vector_type(4))); const i32x4_t i = __builtin_bit_cast(i32x4_t, a); return (f32x4){(float)i[0], (float)i[1], (float)i[2], (float)i[3]}; }
    __device__ __forceinline__ void operator()(const f32x4 (&acc)[2][2][4][2], const Unit& u, int wr, int wc, int fr, int fq) const {
        const int row0 = u.pm * BM + wr * 64 + fr; const int ccol0 = u.pn * BM + wc * 32 + 8 * fq;
        f32x4 cs[2][2];
#pragma unroll
        for (int bj = 0; bj < 2; ++bj)
#pragma unroll
            for (int n = 0; n < 2; ++n) cs[bj][n] = *(const f32x4*)(WINS + ccol0 + bj * HALF + 4 * n);
        if (u.pn < 8) {
            const int sel = u.pn >> 1; bf16_t* base = sel == 0 ? Q : (sel == 1 ? K : (sel == 2 ? V : CB));
            const float sc = sel == 0 ? qscale : 1.f; const int col0 = (u.pn & 1) * 256 + wc * 32 + 8 * fq;
            float kmx[2] = {0.f, 0.f};
#pragma unroll
            for (int ai = 0; ai < 2; ++ai)
#pragma unroll
                for (int m = 0; m < 4; ++m) { const int row = row0 + ai * HALF + m * 16; const float rs = HS[row] * sc; const size_t off = (size_t)row * 512 + col0;
#pragma unroll
                    for (int bj = 0; bj < 2; ++bj) { const f32x4 v0 = cvt4(acc[ai][bj][m][0]) * (cs[bj][0] * rs), v1 = cvt4(acc[ai][bj][m][1]) * (cs[bj][1] * rs);
                        u32x4 w; w.x = cvt_pk_bf16(v0[0], v0[1]); w.y = cvt_pk_bf16(v0[2], v0[3]); w.z = cvt_pk_bf16(v1[0], v1[1]); w.w = cvt_pk_bf16(v1[2], v1[3]);
                        *(u32x4*)(base + off + bj * HALF) = w;
                        if (sel == 1) {
                            float s8 = (v0[0] * v0[0] + v0[1] * v0[1]) + (v0[2] * v0[2] + v0[3] * v0[3]) + (v1[0] * v1[0] + v1[1] * v1[1]) + (v1[2] * v1[2] + v1[3] * v1[3]);
                            { const unsigned ub = __builtin_bit_cast(unsigned, s8); const auto sw_ = __builtin_amdgcn_permlane16_swap(ub, ub, false, false); s8 = __builtin_bit_cast(float, (unsigned)sw_[0]) + __builtin_bit_cast(float, (unsigned)sw_[1]); }
                            { const unsigned ub = __builtin_bit_cast(unsigned, s8); const auto sw_ = __builtin_amdgcn_permlane32_swap(ub, ub, false, false); s8 = __builtin_bit_cast(float, (unsigned)sw_[0]) + __builtin_bit_cast(float, (unsigned)sw_[1]); }
                            kmx[bj] = fmaxf(kmx[bj], s8); } } }
            if (sel == 1) {
#pragma unroll
                for (int bj = 0; bj < 2; ++bj) { float v = kmx[bj];
                    v = fmaxf(v, __builtin_bit_cast(float, __builtin_amdgcn_update_dpp(0, __builtin_bit_cast(int, v), 0xB1, 0xf, 0xf, false))); v = fmaxf(v, __builtin_bit_cast(float, __builtin_amdgcn_update_dpp(0, __builtin_bit_cast(int, v), 0x4E, 0xf, 0xf, false)));
                    v = fmaxf(v, __builtin_bit_cast(float, __builtin_amdgcn_update_dpp(0, __builtin_bit_cast(int, v), 0x141, 0xf, 0xf, false))); v = fmaxf(v, __builtin_bit_cast(float, __builtin_amdgcn_update_dpp(0, __builtin_bit_cast(int, v), 0x140, 0xf, 0xf, false)));
                    if (fr == 0 && fq == 0) atomicMax(KN + ((u.pm >> 3) * 4 + (u.pn & 1) * 2 + bj) * 2 + (wc >> 1), __builtin_bit_cast(unsigned, v * 2.05f)); } }
        } else {
            const int col0 = (u.pn - 8) * 128 + wc * 32 + 8 * fq;
#pragma unroll
            for (int ai = 0; ai < 2; ++ai)
#pragma unroll
                for (int m = 0; m < 4; ++m) { const int row = row0 + ai * HALF + m * 16; const float rs = HS[row]; const size_t off = (size_t)row * 512 + col0;
                    const f32x4 v0 = (cvt4(acc[ai][0][m][0]) * cs[0][0] * rs) * (cvt4(acc[ai][1][m][0]) * cs[1][0] * rs), v1 = (cvt4(acc[ai][0][m][1]) * cs[0][1] * rs) * (cvt4(acc[ai][1][m][1]) * cs[1][1] * rs);
                    u32x4 w; w.x = cvt_pk_bf16(v0[0], v0[1]); w.y = cvt_pk_bf16(v0[2], v0[3]); w.z = cvt_pk_bf16(v1[0], v1[1]); w.w = cvt_pk_bf16(v1[2], v1[3]);
                    *(u32x4*)(GC + off) = w; }
        }
    }
};
template <bool I8> __device__ __forceinline__ f32x4 mma16(bf16x8 a, bf16x8 b, f32x4 c) {
    if constexpr (I8) { typedef int i32x4_t __attribute__((ext_vector_type(4)));
        return __builtin_bit_cast(f32x4, __builtin_amdgcn_mfma_i32_16x16x64_i8(__builtin_bit_cast(i32x4_t, a), __builtin_bit_cast(i32x4_t, b), __builtin_bit_cast(i32x4_t, c), 0, 0, 0)); }
    else return __builtin_amdgcn_mfma_f32_16x16x32_bf16(a, b, c, 0, 0, 0);
}
template <class Epi, class Sched, bool ALIGN_EPI = false, bool SP2 = false, bool I8 = false>
__device__ __forceinline__ void gemm_phase(PG8_LAS unsigned char* lds, const Gemm g, const Sched& S, const Epi& E) {
    const int tid = threadIdx.x, wid = __builtin_amdgcn_readfirstlane(tid >> 6), lane = tid & 63, wr = wid >> 2, wc = wid & 3, fr = lane & 15, fq = lane >> 4;
    const int K = g.K, nt = K / BK;
    unsigned voffA[2], voffB[2];
#pragma unroll
    for (int i = 0; i < 2; ++i) { int R, C; stage_rc(tid * 16 + i * 8192, R, C); const int Rb = Epi::PERM ? ((R & ~31) + perm32(R & 31)) : R;
        voffA[i] = (unsigned)(R * K + C) * 2u; voffB[i] = (unsigned)(Rb * K + C) * 2u; }
    const size_t kstep = (size_t)(BK * 2);
    const size_t hstep = (size_t)HALF * K * 2;
    const size_t tstep = 2 * hstep;
    const unsigned ldsw = (unsigned)wid * 1024u;
    const int aoff = lds_byte(wr * 64 + fr, fq * 8), boff = lds_byte(wc * 32 + fr, fq * 8);
#define PG8_SA(b, h) (((b) * 2 + (h)) * HTB)
#define PG8_SB(b, h) ((4 + (b) * 2 + (h)) * HTB)
#define PG8_STAGE(bufoff, gbase, voff) do { _Pragma("unroll") for (int _i = 0; _i < 2; ++_i) \
        __builtin_amdgcn_global_load_lds((const unsigned*)((const char*)(gbase) + (voff)[_i]), (PG8_LAS unsigned*)(lds + (bufoff) + ldsw + _i * 8192), 16, 0, 0); } while (0)
#define PG8_LDA(dst, b, h) do { _Pragma("unroll") for (int m = 0; m < 4; ++m) _Pragma("unroll") for (int k = 0; k < 2; ++k) dst[m][k] = *(const PG8_LAS bf16x8*)(lds + PG8_SA(b, h) + aoff + m * 2048 + k * 1024); } while (0)
#define PG8_LDB(dst, b, h) do { _Pragma("unroll") for (int n = 0; n < 2; ++n) _Pragma("unroll") for (int k = 0; k < 2; ++k) dst[n][k] = *(const PG8_LAS bf16x8*)(lds + PG8_SB(b, h) + boff + n * 2048 + k * 1024); } while (0)
#define PG8_MMA(ai, bj, At, Bt) do { __builtin_amdgcn_s_setprio(1); _Pragma("unroll") for (int m = 0; m < 4; ++m) _Pragma("unroll") for (int n = 0; n < 2; ++n) _Pragma("unroll") for (int k = 0; k < 2; ++k) \
        acc[ai][bj][m][n] = mma16<I8>(Bt[n][k], At[m][k], acc[ai][bj][m][n]); __builtin_amdgcn_s_setprio(0); } while (0)
#define PG8_WAIT_V(n) asm volatile("s_waitcnt vmcnt(" #n ")" ::: "memory")
#define PG8_WAIT_L(n) asm volatile("s_waitcnt lgkmcnt(" #n ")" ::: "memory")
#define PG8_BAR __builtin_amdgcn_s_barrier()
#define PG8_SCHED __builtin_amdgcn_sched_barrier(0)
    Unit cur, nxt; int ui = 0;
    if (!S.next(0, cur)) return;
    f32x4 acc[2][2][4][2];
#pragma unroll
    for (int a = 0; a < 2; ++a)
#pragma unroll
        for (int b = 0; b < 2; ++b)
#pragma unroll
            for (int m = 0; m < 4; ++m)
#pragma unroll
                for (int n = 0; n < 2; ++n) acc[a][b][m][n] = (f32x4){0.f, 0.f, 0.f, 0.f};
    bf16x8 At[4][2], B0[2][2], B1[2][2];
    const char* cA = (const char*)g.A + (size_t)cur.pm * tstep; const char* cB = (const char*)g.Bt + (size_t)cur.pn * tstep;
    S.a_ready(cur);
    if constexpr (SP2) {
        PG8_STAGE(PG8_SB(0, 0), cB, voffB); PG8_STAGE(PG8_SB(0, 1), cB + hstep, voffB); PG8_STAGE(PG8_SA(0, 0), cA, voffA); PG8_STAGE(PG8_SA(0, 1), cA + hstep, voffA);
        if (wr == 1) PG8_BAR;
        PG8_WAIT_V(2); PG8_BAR;
        PG8_STAGE(PG8_SB(1, 0), cB + kstep, voffB); PG8_STAGE(PG8_SA(1, 0), cA + kstep, voffA); PG8_STAGE(PG8_SB(1, 1), cB + hstep + kstep, voffB);
        PG8_WAIT_V(6); PG8_BAR;
    } else {
        PG8_STAGE(PG8_SB(0, 0), cB, voffB); PG8_STAGE(PG8_SA(0, 0), cA, voffA); PG8_STAGE(PG8_SB(0, 1), cB + hstep, voffB); PG8_STAGE(PG8_SA(0, 1), cA + hstep, voffA);
        if (wr == 1) PG8_BAR;
        PG8_WAIT_V(4); PG8_BAR;
        PG8_STAGE(PG8_SB(1, 0), cB + kstep, voffB); PG8_STAGE(PG8_SA(1, 0), cA + kstep, voffA); PG8_STAGE(PG8_SB(1, 1), cB + hstep + kstep, voffB);
        PG8_WAIT_V(6); PG8_BAR;
    }
    for (;;) {
        const bool has_next = S.next(ui + 1, nxt);
        const char* nA = has_next ? (const char*)g.A + (size_t)nxt.pm * tstep : cA; const char* nB = has_next ? (const char*)g.Bt + (size_t)nxt.pn * tstep : cB;
        for (int t = 0; t < nt; t += 2) {
            const bool last = (t == nt - 2);
            const char* a1 = cA + (size_t)(t + 1) * kstep;
            const char* a2 = last ? nA : cA + (size_t)(t + 2) * kstep; const char* b2 = last ? nB : cB + (size_t)(t + 2) * kstep;
            const char* a3 = a2 + kstep; const char* b3 = b2 + kstep;
            if (last && has_next) S.a_ready(nxt);
            if constexpr (SP2) {
            PG8_LDB(B0, 0, 0); PG8_LDB(B1, 0, 1); PG8_SCHED; PG8_LDA(At, 0, 0); PG8_STAGE(PG8_SA(1, 1), a1 + hstep, voffA);
            PG8_WAIT_V(8); PG8_WAIT_L(0); PG8_BAR; PG8_MMA(0, 0, At, B0); PG8_MMA(0, 1, At, B1); PG8_BAR; PG8_SCHED;
            PG8_LDA(At, 0, 1); PG8_STAGE(PG8_SB(0, 0), b2, voffB); PG8_STAGE(PG8_SB(0, 1), b2 + hstep, voffB); PG8_STAGE(PG8_SA(0, 0), a2, voffA);
            PG8_WAIT_V(8); PG8_WAIT_L(0); PG8_BAR; PG8_MMA(1, 0, At, B0); PG8_MMA(1, 1, At, B1); PG8_BAR; PG8_SCHED;
            PG8_LDB(B0, 1, 0); PG8_LDB(B1, 1, 1); PG8_SCHED; PG8_LDA(At, 1, 0); PG8_STAGE(PG8_SA(0, 1), a2 + hstep, voffA);
            PG8_WAIT_V(8); PG8_WAIT_L(0); PG8_BAR; PG8_MMA(0, 0, At, B0); PG8_MMA(0, 1, At, B1); PG8_BAR; PG8_SCHED;
            PG8_LDA(At, 1, 1); PG8_STAGE(PG8_SB(1, 0), b3, voffB); PG8_STAGE(PG8_SB(1, 1), b3 + hstep, voffB); PG8_STAGE(PG8_SA(1, 0), a3, voffA);
            PG8_WAIT_V(8); PG8_WAIT_L(0); PG8_BAR; PG8_MMA(1, 0, At, B0); PG8_MMA(1, 1, At, B1); PG8_BAR; PG8_SCHED;
            } else {
            PG8_LDB(B0, 0, 0); PG8_SCHED; PG8_LDA(At, 0, 0); PG8_STAGE(PG8_SA(1, 1), a1 + hstep, voffA);
            PG8_WAIT_L(8); PG8_BAR; PG8_WAIT_L(0); PG8_MMA(0, 0, At, B0); PG8_BAR; PG8_SCHED;
            PG8_LDB(B1, 0, 1); PG8_STAGE(PG8_SB(0, 0), b2, voffB);
            PG8_BAR; PG8_WAIT_L(0); PG8_MMA(0, 1, At, B1); PG8_BAR;
            PG8_LDA(At, 0, 1); PG8_STAGE(PG8_SA(0, 0), a2, voffA);
            PG8_BAR; PG8_WAIT_L(0); PG8_MMA(1, 0, At, B0); PG8_BAR; PG8_SCHED;
            PG8_STAGE(PG8_SB(0, 1), b2 + hstep, voffB);
            PG8_WAIT_V(6); PG8_BAR; PG8_MMA(1, 1, At, B1); PG8_BAR;
            PG8_LDB(B0, 1, 0); PG8_SCHED; PG8_LDA(At, 1, 0); PG8_STAGE(PG8_SA(0, 1), a2 + hstep, voffA);
            PG8_WAIT_L(8); PG8_BAR; PG8_WAIT_L(0); PG8_MMA(0, 0, At, B0); PG8_BAR; PG8_SCHED;
            PG8_LDB(B1, 1, 1); PG8_STAGE(PG8_SB(1, 0), b3, voffB);
            PG8_BAR; PG8_WAIT_L(0); PG8_MMA(0, 1, At, B1); PG8_BAR;
            PG8_LDA(At, 1, 1); PG8_STAGE(PG8_SA(1, 0), a3, voffA);
            PG8_BAR; PG8_WAIT_L(0); PG8_MMA(1, 0, At, B0); PG8_BAR; PG8_SCHED;
            PG8_STAGE(PG8_SB(1, 1), b3 + hstep, voffB);
            PG8_WAIT_V(6); PG8_BAR; PG8_MMA(1, 1, At, B1); PG8_BAR;
            }
        }
        if constexpr (ALIGN_EPI) { if (wr == 0) PG8_BAR; }
        if constexpr (!Epi::AFTER_DRAIN) { E(acc, cur, wr, wc, fr, fq); S.done(cur); }
        if (!has_next) break;
#pragma unroll
        for (int a = 0; a < 2; ++a)
#pragma unroll
            for (int b = 0; b < 2; ++b)
#pragma unroll
                for (int m = 0; m < 4; ++m)
#pragma unroll
                    for (int n = 0; n < 2; ++n) acc[a][b][m][n] = (f32x4){0.f, 0.f, 0.f, 0.f};
        cur = nxt; cA = nA; cB = nB; ++ui;
        if constexpr (ALIGN_EPI) { if (wr == 1) PG8_BAR; }
    }
    PG8_WAIT_V(0);
    if constexpr (!ALIGN_EPI) { if (wr == 0) PG8_BAR; }
    PG8_BAR;
    if constexpr (Epi::AFTER_DRAIN) { E.fused(acc, cur, wr, wc, fr, fq, lds, wid, lane); S.done(cur); }
#undef PG8_SA
#undef PG8_SB
#undef PG8_STAGE
#undef PG8_LDA
#undef PG8_LDB
#undef PG8_MMA
#undef PG8_WAIT_V
#undef PG8_WAIT_L
#undef PG8_BAR
#undef PG8_SCHED
}
}
namespace att {
using bf16x8 = __attribute__((ext_vector_type(8))) short;
using s16x4  = __attribute__((ext_vector_type(4))) short;
using f32x16 = __attribute__((ext_vector_type(16))) float;
using f32x4  = __attribute__((ext_vector_type(4))) float;
using u32x4  = __attribute__((ext_vector_type(4))) unsigned;
typedef unsigned short bf16_t;
constexpr int S = 2048, PITCH = 512, SHM_K = 16384, SHM_V = 16384;
constexpr int OFF_XO = 0, XO_LD = 132, OFF_WS = 69632, LDS_BYTES = OFF_WS + 8 * 64 * 4;
constexpr float THR = 8.f;
#define KSWZ(row, colB) ((row) * 256 + ((colB) ^ (((row) & 7) << 4)))
#define SBAR() __builtin_amdgcn_sched_barrier(0)
__device__ __forceinline__ int crow(int r, int hi) { return (r & 3) + 8 * (r >> 2) + 4 * hi; }
__device__ __forceinline__ unsigned cvtpk(float lo, float hi) { unsigned r; asm volatile("v_cvt_pk_bf16_f32 %0, %1, %2" : "=v"(r) : "v"(lo), "v"(hi)); return r; }
__device__ __forceinline__ int v_st(int k, int c) { const int kk = (k & ~0xC) | ((k & 4) << 1) | ((k & 8) >> 1); return ((kk >> 3) * 4 + (c >> 5)) * 512 + ((kk & 7) * 32 + (c & 31)) * 2; }
__device__ __forceinline__ int v_rd_base(int lane) { return ((lane & 3) << 3) | (((lane >> 2) & 3) << 6) | (((lane >> 4) & 1) << 5) | (((lane >> 5) & 1) << 8); }
constexpr int v_rd_off(int d0, int ks, int half) { return d0 * 512 + ks * 4096 + half * 2048; }
template <int OFF> __device__ __forceinline__ s16x4 tr_read(int vb) { s16x4 r; asm volatile("ds_read_b64_tr_b16 %0, %1 offset:%2" : "=&v"(r) : "v"(vb), "i"(OFF) : "memory"); return r; }
template <int D0> __device__ __forceinline__ void pv_one(f32x16& od, int vb, bf16x8 pa0, bf16x8 pa1, bf16x8 pa2, bf16x8 pa3) {
  const s16x4 l0 = tr_read<v_rd_off(D0, 0, 0)>(vb), h0 = tr_read<v_rd_off(D0, 0, 1)>(vb), l1 = tr_read<v_rd_off(D0, 1, 0)>(vb), h1 = tr_read<v_rd_off(D0, 1, 1)>(vb);
  const s16x4 l2 = tr_read<v_rd_off(D0, 2, 0)>(vb), h2 = tr_read<v_rd_off(D0, 2, 1)>(vb), l3 = tr_read<v_rd_off(D0, 3, 0)>(vb), h3 = tr_read<v_rd_off(D0, 3, 1)>(vb);
  asm volatile("s_waitcnt lgkmcnt(0)" ::: "memory"); SBAR();
#define PKV(L, H) (bf16x8){L[0], L[1], L[2], L[3], H[0], H[1], H[2], H[3]}
  od = __builtin_amdgcn_mfma_f32_32x32x16_bf16(pa0, PKV(l0, h0), od, 0, 0, 0);
  od = __builtin_amdgcn_mfma_f32_32x32x16_bf16(pa1, PKV(l1, h1), od, 0, 0, 0);
  od = __builtin_amdgcn_mfma_f32_32x32x16_bf16(pa2, PKV(l2, h2), od, 0, 0, 0);
  od = __builtin_amdgcn_mfma_f32_32x32x16_bf16(pa3, PKV(l3, h3), od, 0, 0, 0);
#undef PKV
}
__device__ __forceinline__ void pv_d0(f32x16* o, int vb, bf16x8 pa0, bf16x8 pa1, bf16x8 pa2, bf16x8 pa3) {
  pv_one<0>(o[0], vb, pa0, pa1, pa2, pa3); pv_one<1>(o[1], vb, pa0, pa1, pa2, pa3); pv_one<2>(o[2], vb, pa0, pa1, pa2, pa3); pv_one<3>(o[3], vb, pa0, pa1, pa2, pa3);
}

__device__ __forceinline__ void attn_unit(int b, int h, int u, const bf16_t* __restrict__ Q, const bf16_t* __restrict__ K, const bf16_t* __restrict__ V, bf16_t* __restrict__ MIX,
                                          const float* __restrict__ gnorm, float lam, float sl2, char* lds, float kn2a, float kn2b) {
  int tid_ = threadIdx.x; asm volatile("" : "+v"(tid_));
  const int tid = tid_, lane = tid & 63, r32 = lane & 31, hi = lane >> 5;
  const int wid = __builtin_amdgcn_readfirstlane(tid >> 6);
  const int c = wid >> 2, rb = wid & 3;
  const int q0 = u * 128, mychunk = 2 * u + (rb >> 1), NT = 2 * u + 2;
  const int qpos = q0 + rb * 32 + r32;
  const size_t rowbase = (size_t)b * S;
  char* V_lds = lds; char* K_lds = lds + 2 * SHM_V;
  float* ws = (float*)(lds + OFF_WS) + wid * 64;
  bf16x8 qr[4];
  { const bf16_t* Qw = Q + (rowbase + qpos) * PITCH + h * 128 + c * 64 + hi * 8;
#pragma unroll
    for (int d0 = 0; d0 < 4; ++d0) qr[d0] = *reinterpret_cast<const bf16x8*>(Qw + d0 * 16); }
  { float qn = 0.f;
#pragma unroll
    for (int d0 = 0; d0 < 4; ++d0) {
#pragma unroll
      for (int e = 0; e < 8; ++e) { const float x = __uint_as_float((unsigned)(unsigned short)qr[d0][e] << 16); qn = fmaf(x, x, qn); } }
    { auto rr = __builtin_amdgcn_permlane32_swap(__float_as_uint(qn), __float_as_uint(qn), false, false); qn = __uint_as_float(rr[0]) + __uint_as_float(rr[1]); }
    qn = fmaxf(qn, __builtin_bit_cast(float, __builtin_amdgcn_update_dpp(0, __builtin_bit_cast(int, qn), 0xB1, 0xf, 0xf, false))); qn = fmaxf(qn, __builtin_bit_cast(float, __builtin_amdgcn_update_dpp(0, __builtin_bit_cast(int, qn), 0x4E, 0xf, 0xf, false)));
    qn = fmaxf(qn, __builtin_bit_cast(float, __builtin_amdgcn_update_dpp(0, __builtin_bit_cast(int, qn), 0x141, 0xf, 0xf, false))); qn = fmaxf(qn, __builtin_bit_cast(float, __builtin_amdgcn_update_dpp(0, __builtin_bit_cast(int, qn), 0x140, 0xf, 0xf, false)));
    { auto rr = __builtin_amdgcn_permlane16_swap(__float_as_uint(qn), __float_as_uint(qn), false, false); qn = fmaxf(__uint_as_float(rr[0]), __uint_as_float(rr[1])); }
    if (lane == 0) ws[0] = qn; }
  const int sr = tid >> 4, sc = (tid & 15) * 8;
  const int vst0 = v_st(sr, sc), vst1 = v_st(32 + sr, sc);
  const int kst0 = KSWZ(sr, sc * 2), kst1 = KSWZ(32 + sr, sc * 2);
  const int vb0 = (int)(uintptr_t)V_lds + v_rd_base(lane);
  const bf16_t* Kg = K + rowbase * PITCH + h * 128 + sc; const bf16_t* Vg = V + rowbase * PITCH + h * 128 + sc;
  bf16x8 vs0, vs1, ks0, ks1;
#define SLOAD(k0) do { vs0 = *reinterpret_cast<const bf16x8*>(Vg + (size_t)((k0) + sr) * PITCH); vs1 = *reinterpret_cast<const bf16x8*>(Vg + (size_t)((k0) + 32 + sr) * PITCH); \
    ks0 = *reinterpret_cast<const bf16x8*>(Kg + (size_t)((k0) + sr) * PITCH); ks1 = *reinterpret_cast<const bf16x8*>(Kg + (size_t)((k0) + 32 + sr) * PITCH); } while (0)
#define SWRITE(bf) do { *(bf16x8*)(V_lds + (bf) * SHM_V + vst0) = vs0; *(bf16x8*)(V_lds + (bf) * SHM_V + vst1) = vs1; \
    *(bf16x8*)(K_lds + (bf) * SHM_K + kst0) = ks0; *(bf16x8*)(K_lds + (bf) * SHM_K + kst1) = ks1; } while (0)
  float m = 0.f, l = 0.f; f32x16 o[4];
#pragma unroll
  for (int d = 0; d < 4; ++d) o[d] = f32x16{};
  bool started = false;
  SLOAD((NT - 1) * 64); SWRITE(0); __syncthreads();
  int NTe = NT;
  { const float* wsb = (const float*)(lds + OFF_WS);
    const float qa = fmaxf(fmaxf(wsb[0], wsb[64]), fmaxf(wsb[128], wsb[192])), qb = fmaxf(fmaxf(wsb[256], wsb[320]), fmaxf(wsb[384], wsb[448]));
    const float B = 1.02f * sqrtf(fmaxf(qa * kn2a, qb * kn2b));
    const float D = (33.f + 2.f * B) / sl2 + 63.f;
    const float jm = floorf(((float)(128 * u - 63) - D) * (1.f / 64.f)) + 1.f;
    if (kn2a > 0.f && kn2b > 0.f && B == B && B < 1e30f && jm > 0.f) { const int jmin = (int)jm < NT - 2 ? (int)jm : NT - 2; NTe = NT - jmin; }
    __syncthreads(); }
#pragma unroll 1
  for (int it = 0; it < NTe; ++it) {
    const int j = NT - 1 - it, bf = it & 1;
    if (it + 1 < NTe) SLOAD((j - 1) * 64);
    if (j <= mychunk) {
      f32x16 p0, p1;
      if (j != mychunk) { const float t0 = sl2 * (float)(64 * j + 4 * hi - qpos) - m;
#pragma unroll
        for (int r = 0; r < 16; ++r) { p0[r] = fmaf(sl2, (float)((r & 3) + 8 * (r >> 2)), t0); p1[r] = p0[r] + 32.f * sl2; } }
      else {
#pragma unroll
        for (int r = 0; r < 16; ++r) { const float d = (float)(64 * j + crow(r, hi) - qpos); p0[r] = -sl2 * fabsf(d) - m; p1[r] = -sl2 * fabsf(d + 32.f) - m; } }
      const char* Kb = K_lds + bf * SHM_K;
      __builtin_amdgcn_s_setprio(1);
#pragma unroll
      for (int d0 = 0; d0 < 4; ++d0) { const int cbb = ((c * 4 + d0) * 16 + hi * 8) * 2;
        const bf16x8 b0 = *reinterpret_cast<const bf16x8*>(Kb + KSWZ(r32, cbb));
        const bf16x8 b1 = *reinterpret_cast<const bf16x8*>(Kb + KSWZ(32 + r32, cbb));
        p0 = __builtin_amdgcn_mfma_f32_32x32x16_bf16(b0, qr[d0], p0, 0, 0, 0);
        p1 = __builtin_amdgcn_mfma_f32_32x32x16_bf16(b1, qr[d0], p1, 0, 0, 0); }
      __builtin_amdgcn_s_setprio(0);
      float pmax = p0[0];
#pragma unroll
      for (int r = 1; r < 16; ++r) pmax = fmaxf(pmax, p0[r]);
#pragma unroll
      for (int r = 0; r < 16; ++r) pmax = fmaxf(pmax, p1[r]);
      { auto rr = __builtin_amdgcn_permlane32_swap(__float_as_uint(pmax), __float_as_uint(pmax), false, false); pmax = fmaxf(__uint_as_float(rr[0]), __uint_as_float(rr[1])); }
      const bool first = !started;
      if (!started) { started = true; m += pmax;
#pragma unroll
        for (int r = 0; r < 16; ++r) { p0[r] -= pmax; p1[r] -= pmax; } }
      else if (__any(pmax > THR)) { const float delta = fmaxf(pmax, 0.f); m += delta;
#pragma unroll
        for (int r = 0; r < 16; ++r) { p0[r] -= delta; p1[r] -= delta; }
        const float alpha = __builtin_amdgcn_exp2f(-delta); l *= alpha;
        if (hi == 0) ws[r32] = alpha;
        asm volatile("s_waitcnt lgkmcnt(0)" ::: "memory");
#pragma unroll
        for (int r = 0; r < 16; ++r) { const float a = ws[crow(r, hi)];
#pragma unroll
          for (int d = 0; d < 4; ++d) o[d][r] *= a; } }
      if (first || __any(pmax > -33.f)) {
#pragma unroll
        for (int r = 0; r < 16; ++r) { p0[r] = __builtin_amdgcn_exp2f(p0[r]); p1[r] = __builtin_amdgcn_exp2f(p1[r]); }
        float ps = 0.f;
#pragma unroll
        for (int r = 0; r < 16; ++r) ps += p0[r];
#pragma unroll
        for (int r = 0; r < 16; ++r) ps += p1[r];
        { auto rr = __builtin_amdgcn_permlane32_swap(__float_as_uint(ps), __float_as_uint(ps), false, false); ps = __uint_as_float(rr[0]) + __uint_as_float(rr[1]); }
        l += ps;
        bf16x8 pa0, pa1, pa2, pa3;
#define PK4(P, BASE, OUT) do { unsigned a0 = cvtpk(P[BASE + 0], P[BASE + 1]), a1 = cvtpk(P[BASE + 2], P[BASE + 3]);   \
      unsigned b0_ = cvtpk(P[BASE + 4], P[BASE + 5]), b1_ = cvtpk(P[BASE + 6], P[BASE + 7]);                              \
      auto r0 = __builtin_amdgcn_permlane32_swap(a0, b0_, false, false); auto r1 = __builtin_amdgcn_permlane32_swap(a1, b1_, false, false); \
      u32x4 w = {r0[0], r1[0], r0[1], r1[1]}; OUT = __builtin_bit_cast(bf16x8, w); } while (0)
        PK4(p0, 0, pa0); PK4(p0, 8, pa1); PK4(p1, 0, pa2); PK4(p1, 8, pa3);
#undef PK4
        __builtin_amdgcn_s_setprio(1); pv_d0(o, vb0 + bf * SHM_V, pa0, pa1, pa2, pa3); __builtin_amdgcn_s_setprio(0);
      }
    }
    if (it + 1 < NTe) SWRITE(bf ^ 1);
    __syncthreads();
  }
#undef SLOAD
#undef SWRITE
  if (hi == 0) ws[r32] = l;
  asm volatile("s_waitcnt lgkmcnt(0)" ::: "memory");
  float rli[16];
#pragma unroll
  for (int r = 0; r < 16; ++r) rli[r] = 1.f / ws[crow(r, hi)];
  float* XO = (float*)(lds + OFF_XO) + rb * (32 * XO_LD);
  if (c == 1) {
#pragma unroll
    for (int r = 0; r < 16; ++r)
#pragma unroll
      for (int d0 = 0; d0 < 4; ++d0) XO[crow(r, hi) * XO_LD + d0 * 32 + r32] = lam * o[d0][r] * rli[r];
  }
  __syncthreads();
  if (c == 0) {
#pragma unroll
    for (int r = 0; r < 16; ++r)
#pragma unroll
      for (int d0 = 0; d0 < 4; ++d0) { float* p = &XO[crow(r, hi) * XO_LD + d0 * 32 + r32]; *p = o[d0][r] * rli[r] - *p; }
    asm volatile("s_waitcnt lgkmcnt(0)" ::: "memory");
    const int row = lane >> 1, half = lane & 1; const float* rp = XO + row * XO_LD + half * 64;
    f32x4 v[16]; float ss = 0.f;
#pragma unroll
    for (int i = 0; i < 16; ++i) { v[i] = *(const f32x4*)(rp + 4 * i); ss += (v[i][0] * v[i][0] + v[i][1] * v[i][1]) + (v[i][2] * v[i][2] + v[i][3] * v[i][3]); }
    ss += __builtin_bit_cast(float, __builtin_amdgcn_update_dpp(0, __builtin_bit_cast(int, ss), 0xB1, 0xf, 0xf, false));
    const float rn = 0.8f / sqrtf(ss * (1.f / 128.f) + 1e-6f);
    bf16_t* op = MIX + (rowbase + q0 + rb * 32 + row) * 1024 + h * 128 + half * 64;
    const float* gp = gnorm + half * 64;
#pragma unroll
    for (int k = 0; k < 8; ++k) { const f32x4 ga = *(const f32x4*)(gp + 8 * k), gb = *(const f32x4*)(gp + 8 * k + 4); const f32x4 a = v[2 * k] * ga * rn, bq = v[2 * k + 1] * gb * rn;
      u32x4 w; w.x = cvtpk(a[0], a[1]); w.y = cvtpk(a[2], a[3]); w.z = cvtpk(bq[0], bq[1]); w.w = cvtpk(bq[2], bq[3]); *(u32x4*)(op + 8 * k) = w; }
  }
  __syncthreads();
}
#undef KSWZ
#undef SBAR
}

#define GAS __attribute__((address_space(1)))
#define LAS __attribute__((address_space(3)))
typedef unsigned short bf16;
typedef unsigned v4u __attribute__((ext_vector_type(4)));
typedef float f32x4 __attribute__((ext_vector_type(4)));
typedef short bf16x8 __attribute__((ext_vector_type(8)));
typedef GAS unsigned gu32;
typedef GAS unsigned long long gu64;
#define RLX_AGENT __ATOMIC_RELAXED, __HIP_MEMORY_SCOPE_AGENT
#define LDS_WAIT() asm volatile("s_waitcnt lgkmcnt(0)" ::: "memory")
#define VM_WAIT() asm volatile("s_waitcnt vmcnt(0)" ::: "memory")
__device__ __forceinline__ unsigned long long rt() { return __builtin_amdgcn_s_memrealtime(); }
__device__ __forceinline__ unsigned f2bf(float f) { unsigned u = __builtin_bit_cast(unsigned, f); return (u + 0x7fffu + ((u >> 16) & 1u)) >> 16; }
__device__ __forceinline__ unsigned pk2(float lo, float hi) { unsigned r; asm("v_cvt_pk_bf16_f32 %0, %1, %2" : "=v"(r) : "v"(lo), "v"(hi)); return r; }

#define XB_TMO      128
#define XB_XCNT(j)  (256  + 64 * (j))
#define XB_XSUB(j)  (1280 + 64 * (j))
#define XB_XGEN(j)  (2304 + 64 * (j))
#define XB_TOP      3328
#define XB_TOPGEN   3392
#define XCD_BAR_WORDS 3456
#define XB_SPIN_CAP (1u << 18)

__device__ __forceinline__ unsigned xb_ld(unsigned* p)              { return __hip_atomic_load(p, __ATOMIC_RELAXED, __HIP_MEMORY_SCOPE_AGENT); }
__device__ __forceinline__ unsigned xb_add(unsigned* p, unsigned v) { return __hip_atomic_fetch_add(p, v, __ATOMIC_RELAXED, __HIP_MEMORY_SCOPE_AGENT); }
__device__ __forceinline__ unsigned xb_xcc_id() { return (unsigned)__builtin_amdgcn_s_getreg((3 << 11) | 20) & 0xFu; }
#define XB_SPIN(cond, bar) do { unsigned _sp = 0; while (cond) { __builtin_amdgcn_s_sleep(1); \
    if ((++_sp & 255u) == 0u) { if (xb_ld(&(bar)[XB_TMO])) break; if (_sp > XB_SPIN_CAP) { atomicAdd(&(bar)[XB_TMO], 1u); break; } } } } while (0)

struct XcdBarrier {
    unsigned* bar; unsigned x;
    volatile LAS unsigned* st;
};

__device__ __forceinline__ XcdBarrier xcd_barrier_post(unsigned* bar, volatile LAS unsigned* st) {
    XcdBarrier b; b.bar = bar; b.x = xb_xcc_id(); b.st = st;
    if (threadIdx.x == 0) (void)xb_add(&bar[XB_XCNT(b.x)], 1u);
    return b;
}
__device__ __forceinline__ void xcd_barrier_complete(unsigned* bar, unsigned x, unsigned& nloc, unsigned& nx) {
    const unsigned G = gridDim.x * gridDim.y * gridDim.z;
    unsigned sum, cnt, mine, sp = 0u;
    for (;;) {
        sum = 0u; cnt = 0u; mine = 0u;
#pragma unroll
        for (unsigned j = 0; j < 16; ++j) { const unsigned c = xb_ld(&bar[XB_XCNT(j)]); sum += c; cnt += (c > 0u) ? 1u : 0u; mine = (j == x) ? c : mine; }
        if (sum == G) break;
        __builtin_amdgcn_s_sleep(1);
        if ((++sp & 255u) == 0u) { if (xb_ld(&bar[XB_TMO])) break; if (sp > XB_SPIN_CAP) { atomicAdd(&bar[XB_TMO], 1u); break; } }
    }
    nloc = mine > 0u ? mine : 1u; nx = cnt > 0u ? cnt : 1u;
}

__device__ __forceinline__ void xcd_barrier(const XcdBarrier& b) {
    asm volatile("s_waitcnt vmcnt(0)" ::: "memory");
    __syncthreads();
    if (threadIdx.x == 0) {
        unsigned* bar = b.bar;
        __builtin_amdgcn_s_waitcnt(0);
        unsigned nloc = b.st[0], nx = b.st[1];
        if (nloc == 0u) { xcd_barrier_complete(bar, b.x, nloc, nx); b.st[0] = nloc; b.st[1] = nx; }
        const unsigned old = xb_add(&bar[XB_XSUB(b.x)], 1u);
        const unsigned gen = old / nloc;
        if (old + 1u == (gen + 1u) * nloc) {
            __builtin_amdgcn_fence(__ATOMIC_RELEASE, "agent");
            asm volatile("s_waitcnt vmcnt(0)" ::: "memory");
            const unsigned og = xb_add(&bar[XB_TOP], 1u);
            const unsigned tg = og / nx;
            if (og + 1u == (tg + 1u) * nx) xb_add(&bar[XB_TOPGEN], 1u);
            else XB_SPIN(xb_ld(&bar[XB_TOPGEN]) == tg, bar);
            __builtin_amdgcn_fence(__ATOMIC_ACQUIRE, "agent");
            asm volatile("s_waitcnt vmcnt(0)" ::: "memory");
        } else {
            XB_SPIN(xb_ld(&bar[XB_TOPGEN]) == gen, bar);
            __builtin_amdgcn_fence(__ATOMIC_ACQUIRE, "agent");
            asm volatile("s_waitcnt vmcnt(0)" ::: "memory");
        }
    }
    __syncthreads();
}
constexpr int NWAVES = 8;
constexpr int N_LAUNCHES = MK_N_LAUNCHES;
constexpr int N_PHASES = 12;
constexpr int BATCH = 16, SEQ = 2048, DM = 1024, T = BATCH * SEQ;
constexpr int IN_COLS = 3072, NEXP = 16384;
constexpr float EPS = 1e-6f;
constexpr size_t MiB = 1u << 20;
constexpr size_t WS_CTL = 0, CTL_ZERO_BYTES = 32768;
constexpr size_t WS_MODP = 20 * MiB;
constexpr int NKC = 16;
constexpr size_t WS_MOD = 4 * MiB;
constexpr size_t WS_WIN = 8 * MiB, WS_WO = 14 * MiB, WS_WK = 16 * MiB;
constexpr size_t WS_U8 = 32 * MiB, WS_V8 = 48 * MiB;
constexpr float USCALE = 800.f, VSCALE = 70.f;
constexpr size_t WS_WKF = 160 * MiB;
constexpr size_t WS_WINF = 168 * MiB, WS_WOF = 180 * MiB;
constexpr size_t WS_WKS = 7 * MiB, WS_WINS = 7 * MiB + 16384, WS_WOS = 7 * MiB + 32768;
constexpr size_t WS_WSC = 6 * MiB;
constexpr size_t WS_H8 = 64 * MiB;
constexpr size_t WS_HS = 5 * MiB;
constexpr size_t WS_Y = 384 * MiB;
constexpr size_t WS_PART = 224 * MiB;
constexpr size_t WS_W = 352 * MiB;
constexpr size_t WS_H = 96 * MiB;
constexpr size_t WS_DELTA = 448 * MiB;
constexpr size_t WS_IDX = 192 * MiB, WS_GW = 208 * MiB;
constexpr size_t WS_Q = 224 * MiB, WS_K = 256 * MiB, WS_VV = 288 * MiB, WS_CB = 320 * MiB, WS_GC = 352 * MiB;
constexpr size_t WS_MIX = 384 * MiB;
constexpr size_t WS_SC = 224 * MiB;
constexpr size_t WS_END = 512 * MiB;
constexpr int CW_BAR = 4096, CW_XRANK = 2048, CW_KN = 3200;
constexpr int RING_BYTES = 131072, LDSCTL_OFF = RING_BYTES, MISC_OFF = LDSCTL_OFF + 320, LDS_BYTES = 147456;

typedef __bf16 bf16x2_t __attribute__((ext_vector_type(2)));
__device__ __forceinline__ float bflo(unsigned w) { return __uint_as_float(w << 16); }
__device__ __forceinline__ float bfhi(unsigned w) { return __uint_as_float(w & 0xffff0000u); }
__device__ __forceinline__ float dot2bf(unsigned a, unsigned b, float acc) { return __builtin_amdgcn_fdot2_f32_bf16(__builtin_bit_cast(bf16x2_t, a), __builtin_bit_cast(bf16x2_t, b), acc, false); }
#define DPPF(X, CTRL) __builtin_bit_cast(float, __builtin_amdgcn_update_dpp(0, __builtin_bit_cast(int, (X)), (CTRL), 0xf, 0xf, false))
__device__ __forceinline__ float row16_sum(float v) { v += DPPF(v, 0xB1); v += DPPF(v, 0x4E); v += DPPF(v, 0x141); v += DPPF(v, 0x140); return v; }
__device__ __forceinline__ float row16_max(float v) { v = fmaxf(v, DPPF(v, 0xB1)); v = fmaxf(v, DPPF(v, 0x4E)); v = fmaxf(v, DPPF(v, 0x141)); v = fmaxf(v, DPPF(v, 0x140)); return v; }
__device__ __forceinline__ float wave_sum(float v) {
    v = row16_sum(v);
    { const unsigned u = __builtin_bit_cast(unsigned, v); const auto s = __builtin_amdgcn_permlane16_swap(u, u, false, false); v = __builtin_bit_cast(float, (unsigned)s[0]) + __builtin_bit_cast(float, (unsigned)s[1]); }
    { const unsigned u = __builtin_bit_cast(unsigned, v); const auto s = __builtin_amdgcn_permlane32_swap(u, u, false, false); v = __builtin_bit_cast(float, (unsigned)s[0]) + __builtin_bit_cast(float, (unsigned)s[1]); }
    return v;
}
__device__ __forceinline__ float wave_max(float v) {
    v = row16_max(v);
    { const unsigned u = __builtin_bit_cast(unsigned, v); const auto s = __builtin_amdgcn_permlane16_swap(u, u, false, false); v = fmaxf(__builtin_bit_cast(float, (unsigned)s[0]), __builtin_bit_cast(float, (unsigned)s[1])); }
    { const unsigned u = __builtin_bit_cast(unsigned, v); const auto s = __builtin_amdgcn_permlane32_swap(u, u, false, false); v = fmaxf(__builtin_bit_cast(float, (unsigned)s[0]), __builtin_bit_cast(float, (unsigned)s[1])); }
    return v;
}
#ifndef ATT_REP
#define ATT_REP 1
#endif
struct Args { const float* in[20]; float* out; unsigned char* ws; int ph_lo, ph_hi, li, pad; };
struct Frame {
    LAS unsigned char* lds; unsigned char* ldsg;
    int tid, lane, wave, vcu, G, gw, NGW, xcc, xrank;
};

__device__ __forceinline__ unsigned q8x4(float a, float b, float c, float d, float s) {
    const float M = 12582912.f;
    const unsigned ua = __builtin_bit_cast(unsigned, fmaf(a, s, M)), ub = __builtin_bit_cast(unsigned, fmaf(b, s, M)), uc = __builtin_bit_cast(unsigned, fmaf(c, s, M)), ud = __builtin_bit_cast(unsigned, fmaf(d, s, M));
    const unsigned lo = __builtin_amdgcn_perm(ub, ua, 0x0c0c0400u), hi = __builtin_amdgcn_perm(ud, uc, 0x0c0c0400u);
    return lo | (hi << 16);
}
__device__ __forceinline__ void tab_store_i8(unsigned char* tab, int e, int q, int lane, f32x4 x, float s) {
    const float lim = 127.f / s;
    const unsigned w = q8x4(__builtin_amdgcn_fmed3f(x[0], -lim, lim), __builtin_amdgcn_fmed3f(x[1], -lim, lim), __builtin_amdgcn_fmed3f(x[2], -lim, lim), __builtin_amdgcn_fmed3f(x[3], -lim, lim), s);
    *(GAS unsigned*)(tab + (size_t)(2 * q + (lane >> 5)) * ((size_t)NEXP * 256) + (size_t)e * 256 + ((4 * lane) & 127)) = w;
}
__device__ __forceinline__ void transpose_item(const float* W, int K, int N, float* WT, int k0, int n0, int out_row0, LAS float* scr, int lane) {
#pragma unroll
    for (int i = 0; i < 32; ++i) { const int kk = 2 * i + (lane >> 5); scr[kk * 33 + (lane & 31)] = __builtin_nontemporal_load(W + (size_t)(k0 + kk) * N + n0 + (lane & 31)); }
    LDS_WAIT(); asm volatile("" ::: "memory");
    const int c = lane & 7;
#pragma unroll
    for (int j = 0; j < 4; ++j) { const int n = (lane >> 3) + 8 * j; const LAS float* s = scr + (8 * c) * 33 + n;
        GAS f32x4* op = (GAS f32x4*)(WT + (size_t)(out_row0 + n) * K + k0 + 8 * c);
        op[0] = (f32x4){s[0 * 33], s[1 * 33], s[2 * 33], s[3 * 33]}; op[1] = (f32x4){s[4 * 33], s[5 * 33], s[6 * 33], s[7 * 33]}; }
    LDS_WAIT(); asm volatile("" ::: "memory");
}
__device__ __forceinline__ int win_row(int n) {
    if (n < 2048) return n;
    if (n < 2560) { const int j = n - 2048; return (8 + (j >> 7)) * 256 + (j & 127); }
    const int j = n - 2560; return (8 + (j >> 7)) * 256 + 128 + (j & 127);
}
__device__ __forceinline__ void phase0(const Frame& F, const Args& a) {
    const float* c = a.in[1]; const float* ada_w = a.in[2];
    const float* w_in = a.in[5]; const float* w_o = a.in[13]; const float* wq = a.in[15]; const float* keys = a.in[16];
    unsigned char* ws = a.ws;
    const int lane = F.lane;
    const int rgw = F.gw, RNGW = F.NGW;
    {
        typedef float f32x16_t __attribute__((ext_vector_type(16)));
        float* WK = (float*)(ws + WS_WKF);
        const int l31 = lane & 31, lh = lane >> 5;
        LAS f32x4* tile = (LAS f32x4*)(F.lds + F.wave * 16384);
        for (int it = rgw; it < 16 * 4 * 32; it += RNGW) {
            const int hp = it >> 7, n0 = ((it >> 5) & 3) * 32, k0 = (it & 31) * 32;
            f32x4 av[16], bv[16];
            {
                f32x4 tk[16], tq[16];
#pragma unroll
                for (int i = 0; i < 16; ++i) tk[i] = *(const GAS f32x4*)(keys + (size_t)hp * 16384 + (size_t)(n0 + 2 * i + lh) * 128 + 4 * l31);
#pragma unroll
                for (int i = 0; i < 16; ++i) tq[i] = *(const GAS f32x4*)(wq + (size_t)(k0 + 2 * i + lh) * 2048 + hp * 128 + 4 * l31);
#pragma unroll
                for (int i = 0; i < 16; ++i) tile[(2 * i + lh) * 32 + (l31 ^ (2 * i + lh))] = tk[i];
                LDS_WAIT(); asm volatile("" ::: "memory");
#pragma unroll
                for (int q = 0; q < 16; ++q) av[q] = tile[l31 * 32 + ((16 * lh + q) ^ l31)];
                LDS_WAIT(); asm volatile("" ::: "memory");
#pragma unroll
                for (int i = 0; i < 16; ++i) tile[(2 * i + lh) * 32 + (l31 ^ (2 * i + lh))] = tq[i];
                LDS_WAIT(); asm volatile("" ::: "memory");
#pragma unroll
                for (int q = 0; q < 16; ++q) bv[q] = tile[l31 * 32 + ((16 * lh + q) ^ l31)];
                LDS_WAIT(); asm volatile("" ::: "memory");
            }
            f32x16_t acc = {}, acc1 = {}, acc2 = {}, acc3 = {};
#pragma unroll
            for (int q = 0; q < 16; ++q) {
                acc = __builtin_amdgcn_mfma_f32_32x32x2f32(av[q][0], bv[q][0], acc, 0, 0, 0); acc1 = __builtin_amdgcn_mfma_f32_32x32x2f32(av[q][1], bv[q][1], acc1, 0, 0, 0);
                acc2 = __builtin_amdgcn_mfma_f32_32x32x2f32(av[q][2], bv[q][2], acc2, 0, 0, 0); acc3 = __builtin_amdgcn_mfma_f32_32x32x2f32(av[q][3], bv[q][3], acc3, 0, 0, 0); }
            acc = (acc + acc1) + (acc2 + acc3);
            float* op = WK + (size_t)(hp * 128 + n0) * 1024 + k0 + l31;
#pragma unroll
            for (int r = 0; r < 16; ++r) op[(size_t)((r & 3) + 8 * (r >> 2) + 4 * lh) * 1024] = acc[r];
        }
    }
    LAS float* scr = (LAS float*)(F.lds + F.wave * 16384);
    {
        float* MODP = (float*)(ws + WS_MODP); float* WIN = (float*)(ws + WS_WINF); float* WO = (float*)(ws + WS_WOF);
        constexpr int I_IN = 16 * 96, I_O = 16 * 32, I_B = NKC * 96;
        static_assert(I_B <= I_IN + I_O, "every mod-partial item rides on a transpose item");
        const int l15 = lane & 15, lq = lane >> 4;
        for (int it = rgw; it < I_IN + I_O; it += RNGW) {
            const bool isin = it < I_IN; const int r_ = isin ? it : it - I_IN, kb = isin ? r_ / 96 : r_ / 32, nb = isin ? r_ % 96 : r_ % 32;
            const float* W = isin ? w_in : w_o; const int N = isin ? 3072 : 1024, k0 = kb * 64, n0 = nb * 32, orow0 = isin ? win_row(n0) : n0; float* WT = isin ? WIN : WO;
            float t[32];
#pragma unroll
            for (int i = 0; i < 32; ++i) { const int kk = 2 * i + (lane >> 5); t[i] = __builtin_nontemporal_load(W + (size_t)(k0 + kk) * N + n0 + (lane & 31)); }
            const bool hasb = it < I_B; const int itb = hasb ? it : I_B - 1;
            const int kc = itb / 96, cc = itb % 96, col0 = cc * 64;
            const float* wp = ada_w + (size_t)(kc * 64 + lq) * 6144 + col0 + l15;
            const float* cp = c + l15 * 1024 + kc * 64 + lq;
            float cvv[16], w[64];
#pragma unroll
            for (int s = 0; s < 16; ++s) cvv[s] = cp[4 * s];
#pragma unroll
            for (int s = 0; s < 16; ++s)
#pragma unroll
                for (int j = 0; j < 4; ++j) w[4 * s + j] = __builtin_nontemporal_load(wp + (size_t)(4 * s) * 6144 + 16 * j);
#pragma unroll
            for (int i = 0; i < 32; ++i) { const int kk = 2 * i + (lane >> 5); scr[kk * 33 + (lane & 31)] = t[i]; }
            LDS_WAIT(); asm volatile("" ::: "memory");
            { const int c8 = lane & 7;
#pragma unroll
              for (int j = 0; j < 4; ++j) { const int n = (lane >> 3) + 8 * j; const LAS float* s = scr + (8 * c8) * 33 + n;
                GAS f32x4* op = (GAS f32x4*)(WT + (size_t)(orow0 + n) * 1024 + k0 + 8 * c8);
                op[0] = (f32x4){s[0 * 33], s[1 * 33], s[2 * 33], s[3 * 33]}; op[1] = (f32x4){s[4 * 33], s[5 * 33], s[6 * 33], s[7 * 33]}; } }
            LDS_WAIT(); asm volatile("" ::: "memory");
#pragma unroll
            for (int s = 0; s < 16; ++s) cvv[s] = cvv[s] / (1.f + expf(-cvv[s]));
            f32x4 acc[4];
#pragma unroll
            for (int j = 0; j < 4; ++j) acc[j] = (f32x4){0.f, 0.f, 0.f, 0.f};
#pragma unroll
            for (int s = 0; s < 16; ++s)
#pragma unroll
                for (int j = 0; j < 4; ++j) acc[j] = __builtin_amdgcn_mfma_f32_16x16x4f32(cvv[s], w[4 * s + j], acc[j], 0, 0, 0);
            if (hasb) {
#pragma unroll
                for (int j = 0; j < 4; ++j)
#pragma unroll
                    for (int r = 0; r < 4; ++r) MODP[(size_t)(kc * 16 + 4 * lq + r) * 6144 + col0 + 16 * j + l15] = acc[j][r];
            }
        }
    }
}

template <bool FROM_PARTIALS, bool ADD_DELTA, bool QUANT8>
__device__ __forceinline__ void norm_rows(const Frame& F, const float* __restrict__ src, const bf16* __restrict__ delta, bf16* __restrict__ dst, unsigned* __restrict__ dst8, float* __restrict__ hs, const float* __restrict__ gvec, const float* __restrict__ modsrc  ,
                                          const float* __restrict__ ada_b, int sh_off, int sc_off) {
    LAS float* sS = (LAS float*)F.lds; LAS float* sH = sS + 1024;
    for (int rb = F.vcu; rb < T / 128; rb += F.G) {
        const int b = rb >> 4;
        {
            const int k0 = F.tid, k1 = F.tid + 512;
            float sc0, sh0, sc1, sh1;
            if (FROM_PARTIALS) {
                float pc0[NKC], ph0[NKC], pc1[NKC], ph1[NKC];
#pragma unroll
                for (int kc = 0; kc < NKC; ++kc) { const float* m = modsrc + (size_t)(kc * 16 + b) * 6144; pc0[kc] = m[sc_off + k0]; ph0[kc] = m[sh_off + k0]; pc1[kc] = m[sc_off + k1]; ph1[kc] = m[sh_off + k1]; }
                sc0 = ada_b[sc_off + k0]; sh0 = ada_b[sh_off + k0]; sc1 = ada_b[sc_off + k1]; sh1 = ada_b[sh_off + k1];
#pragma unroll
                for (int kc = 0; kc < NKC; ++kc) { sc0 += pc0[kc]; sh0 += ph0[kc]; sc1 += pc1[kc]; sh1 += ph1[kc]; }
            } else { const float* m = modsrc + (size_t)b * 6144; sc0 = m[sc_off + k0]; sh0 = m[sh_off + k0]; sc1 = m[sc_off + k1]; sh1 = m[sh_off + k1]; }
            const float g0 = gvec[k0], g1 = gvec[k1];
            sS[k0] = g0 * (1.f + sc0); sH[k0] = sh0; sS[k1] = g1 * (1.f + sc1); sH[k1] = sh1;
        }
        __syncthreads();
        for (int i = 0; i < 16; ++i) {
            const int row = rb * 128 + F.wave * 16 + i;
            const GAS f32x4* xr = (const GAS f32x4*)(src + (size_t)row * 1024) + F.lane;
            f32x4 v[4]; float s = 0.f;
#pragma unroll
            for (int j = 0; j < 4; ++j) { v[j] = __builtin_nontemporal_load(xr + 64 * j);
                if (ADD_DELTA) { const unsigned long long dd = __builtin_nontemporal_load((const GAS unsigned long long*)(delta + (size_t)row * 1024) + F.lane + 64 * j); const unsigned dlo = (unsigned)dd, dhi = (unsigned)(dd >> 32);
                    v[j] = v[j] + (f32x4){bflo(dlo), bfhi(dlo), bflo(dhi), bfhi(dhi)};
                    __builtin_nontemporal_store((unsigned long long)pk2(v[j].x, v[j].y) | ((unsigned long long)pk2(v[j].z, v[j].w) << 32), (GAS unsigned long long*)(dst + (size_t)row * 1024) + F.lane + 64 * j); }
                s += (v[j].x * v[j].x + v[j].y * v[j].y) + (v[j].z * v[j].z + v[j].w * v[j].w); }
            const float tot = wave_sum(s);
            const float r = 1.f / sqrtf(tot * (1.f / 1024.f) + EPS);
            GAS unsigned long long* o8 = (GAS unsigned long long*)(dst + (size_t)row * 1024) + F.lane;
#pragma unroll
            for (int j = 0; j < 4; ++j) { const int k = 4 * F.lane + 256 * j; const f32x4 sc = *(const LAS f32x4*)(sS + k), sh = *(const LAS f32x4*)(sH + k);
                const f32x4 y = v[j] * r * sc + sh; v[j] = y;
                if (!QUANT8) o8[64 * j] = (unsigned long long)pk2(y.x, y.y) | ((unsigned long long)pk2(y.z, y.w) << 32); }
            if (QUANT8) {
                float mx = 0.f;
#pragma unroll
                for (int j = 0; j < 4; ++j) mx = fmaxf(fmaxf(mx, fmaxf(fabsf(v[j].x), fabsf(v[j].y))), fmaxf(fabsf(v[j].z), fabsf(v[j].w)));
                mx = wave_max(mx);
                mx = fmaxf(mx, 1e-20f); const float inv = 127.f / mx;
#pragma unroll
                for (int j = 0; j < 4; ++j) dst8[(size_t)row * 256 + F.lane + 64 * j] = q8x4(v[j].x, v[j].y, v[j].z, v[j].w, inv);
                if (F.lane == 0) hs[row] = mx * (1.f / 127.f);
            }
        }
        __syncthreads();
    }
}
__device__ __forceinline__ void phase1(const Frame& F, const Args& a) {
    unsigned char* ws = a.ws;
    norm_rows<true, false, true>(F, a.in[0], nullptr, (bf16*)(ws + WS_H), (unsigned*)(ws + WS_H8), (float*)(ws + WS_HS), a.in[4], (const float*)(ws + WS_MODP), a.in[3], 0, 1024);
    { const float* WKF = (const float*)(ws + WS_WKF); const float* WINF = (const float*)(ws + WS_WINF); const float* WOF = (const float*)(ws + WS_WOF);
      for (int n = F.gw; n < 2048 + 3072 + 1024; n += F.NGW) {
          const bool isk = n < 2048, isin = !isk && n < 5120; const int r = isk ? n : (isin ? n - 2048 : n - 5120);
          const float* src = (isk ? WKF : (isin ? WINF : WOF)) + (size_t)r * 1024;
          const GAS f32x4* rp = (const GAS f32x4*)src + F.lane; f32x4 v[4];
#pragma unroll
          for (int j = 0; j < 4; ++j) v[j] = __builtin_nontemporal_load(rp + 64 * j);
          if (!isk && !isin) {
              GAS unsigned long long* o8 = (GAS unsigned long long*)((bf16*)(ws + WS_WO) + (size_t)r * 1024) + F.lane;
#pragma unroll
              for (int j = 0; j < 4; ++j) o8[64 * j] = (unsigned long long)pk2(v[j].x, v[j].y) | ((unsigned long long)pk2(v[j].z, v[j].w) << 32);
              continue; }
          float mx = 0.f;
#pragma unroll
          for (int j = 0; j < 4; ++j) mx = fmaxf(fmaxf(mx, fmaxf(fabsf(v[j].x), fabsf(v[j].y))), fmaxf(fabsf(v[j].z), fabsf(v[j].w)));
          mx = wave_max(mx);
          mx = fmaxf(mx, 1e-30f); const float inv = 127.f / mx;
          unsigned* dst = (unsigned*)(ws + (isk ? WS_WK : WS_WIN)) + (size_t)r * 256;
#pragma unroll
          for (int j = 0; j < 4; ++j) dst[F.lane + 64 * j] = q8x4(v[j].x, v[j].y, v[j].z, v[j].w, inv);
          if (F.lane == 0) ((float*)(ws + (isk ? WS_WKS : WS_WINS)))[r] = mx * (1.f / 127.f);
      } }
    const float* MODP = (const float*)(ws + WS_MODP); float* MOD = (float*)(ws + WS_MOD);
    for (int i = F.vcu * 512 + F.tid; i < 16 * 6144; i += F.G * 512) { float s = a.in[3][i % 6144];
#pragma unroll
        for (int kc = 0; kc < NKC; ++kc) s += MODP[(size_t)kc * 98304 + i];
        MOD[i] = s; }
}

__device__ __forceinline__ void phase3(const Frame& F, const Args& a) {
    unsigned char* ws = a.ws;
    const bf16* Q = (const bf16*)(ws + WS_Q); const bf16* K = (const bf16*)(ws + WS_K); const bf16* V = (const bf16*)(ws + WS_VV);
    bf16* MIX = (bf16*)(ws + WS_MIX);
    float lam;
    { float p = a.in[7][F.lane] * a.in[8][F.lane], q = a.in[9][F.lane] * a.in[10][F.lane]; p = wave_sum(p); q = wave_sum(q); lam = expf(p) - expf(q) + 0.2f; }
    static constexpr unsigned ATT_ROWS[16] = {0x0007253fu, 0x1008352fu, 0x300d173eu, 0x200c162eu, 0x210f193du, 0x110e182du, 0x03221b3cu, 0x02121a2cu, 0x31131d3bu, 0x0b321c2bu, 0x0a331f3au, 0x09231e2au, 0x01153639u, 0x06342629u, 0x05243738u, 0x04142728u};
    for (int v = F.vcu; v < 256; v += F.G) {
        const int b = v >> 4; const unsigned row = ATT_ROWS[v & 15];
        for (int i_ = 0; i_ < 4 * ATT_REP; ++i_) { const int hu = (int)((row >> (8 * (i_ & 3))) & 255u), h = hu >> 4, u = hu & 15;
            const float sl2 = exp2f(-2.f * (float)(h + 1)) * 1.4426950408889634f;
            const float* KNf = (const float*)(a.ws + WS_CTL) + CW_KN + (b * 4 + h) * 2;
            att::attn_unit(b, h, u, Q, K, V, MIX, a.in[11] + h * 128, lam, sl2, (char*)F.ldsg, KNf[0], KNf[1]); }
    }
    const bf16* CB = (const bf16*)(ws + WS_CB); const bf16* GC = (const bf16*)(ws + WS_GC);
    const float* cw = a.in[6]; const float* cg = a.in[12];
    const int c0 = 8 * F.lane;
    float w0[8], w1[8], w2[8], gn[8];
#pragma unroll
    for (int k = 0; k < 8; ++k) { w0[k] = cw[c0 + k]; w1[k] = cw[512 + c0 + k]; w2[k] = cw[1024 + c0 + k]; gn[k] = cg[c0 + k]; }
    for (int tg = F.gw; tg < T / 16; tg += F.NGW) {
        const int t0 = tg * 16; const bool first = (t0 % SEQ) == 0;
        float g2[8], g1[8];
        if (first) {
#pragma unroll
            for (int k = 0; k < 8; ++k) { g2[k] = 0.f; g1[k] = 0.f; } }
        else { const v4u a2 = *(const GAS v4u*)(GC + (size_t)(t0 - 2) * 512 + c0), a1 = *(const GAS v4u*)(GC + (size_t)(t0 - 1) * 512 + c0);
            g2[0] = bflo(a2.x); g2[1] = bfhi(a2.x); g2[2] = bflo(a2.y); g2[3] = bfhi(a2.y); g2[4] = bflo(a2.z); g2[5] = bfhi(a2.z); g2[6] = bflo(a2.w); g2[7] = bfhi(a2.w);
            g1[0] = bflo(a1.x); g1[1] = bfhi(a1.x); g1[2] = bflo(a1.y); g1[3] = bfhi(a1.y); g1[4] = bflo(a1.z); g1[5] = bfhi(a1.z); g1[6] = bflo(a1.w); g1[7] = bfhi(a1.w); }
        for (int i = 0; i < 16; ++i) { const int t = t0 + i;
            const v4u ag = __builtin_nontemporal_load((const GAS v4u*)(GC + (size_t)t * 512 + c0)), ab = __builtin_nontemporal_load((const GAS v4u*)(CB + (size_t)t * 512 + c0));
            float g0[8], cb[8], cv[8];
            g0[0] = bflo(ag.x); g0[1] = bfhi(ag.x); g0[2] = bflo(ag.y); g0[3] = bfhi(ag.y); g0[4] = bflo(ag.z); g0[5] = bfhi(ag.z); g0[6] = bflo(ag.w); g0[7] = bfhi(ag.w);
            cb[0] = bflo(ab.x); cb[1] = bfhi(ab.x); cb[2] = bflo(ab.y); cb[3] = bfhi(ab.y); cb[4] = bflo(ab.z); cb[5] = bfhi(ab.z); cb[6] = bflo(ab.w); cb[7] = bfhi(ab.w);
            float s = 0.f;
#pragma unroll
            for (int k = 0; k < 8; ++k) { cv[k] = cb[k] * (w0[k] * g2[k] + w1[k] * g1[k] + w2[k] * g0[k]); s += cv[k] * cv[k]; g2[k] = g1[k]; g1[k] = g0[k]; }
            s = wave_sum(s);
            const float r = 1.f / sqrtf(s * (1.f / 512.f) + EPS);
            v4u o; o.x = pk2(cv[0] * r * gn[0], cv[1] * r * gn[1]); o.y = pk2(cv[2] * r * gn[2], cv[3] * r * gn[3]); o.z = pk2(cv[4] * r * gn[4], cv[5] * r * gn[5]); o.w = pk2(cv[6] * r * gn[6], cv[7] * r * gn[7]);
            *(GAS v4u*)(MIX + (size_t)t * 1024 + 512 + c0) = o; }
    }
}

#define SORT16_NET(CE) CE(0,1) CE(2,3) CE(0,2) CE(1,3) CE(1,2) CE(4,5) CE(6,7) CE(4,6) CE(5,7) CE(5,6) CE(0,4) CE(2,6) CE(2,4) CE(1,5) CE(3,7) CE(3,5) CE(1,2) CE(3,4) CE(5,6) CE(8,9) CE(10,11) CE(8,10) CE(9,11) CE(9,10) CE(12,13) CE(14,15) CE(12,14) CE(13,15) CE(13,14) CE(8,12) CE(10,14) CE(10,12) CE(9,13) CE(11,15) CE(11,13) CE(9,10) CE(11,12) CE(13,14) CE(0,8) CE(4,12) CE(4,8) CE(2,10) CE(6,14) CE(6,10) CE(2,4) CE(6,8) CE(10,12) CE(1,9) CE(5,13) CE(5,9) CE(3,11) CE(7,15) CE(7,11) CE(3,5) CE(7,9) CE(11,13) CE(1,2) CE(3,4) CE(5,6) CE(7,8) CE(9,10) CE(11,12) CE(13,14)
#define BITONIC16_NET(CE) CE(0,8) CE(1,9) CE(2,10) CE(3,11) CE(4,12) CE(5,13) CE(6,14) CE(7,15) CE(0,4) CE(1,5) CE(2,6) CE(3,7) CE(8,12) CE(9,13) CE(10,14) CE(11,15) CE(0,2) CE(1,3) CE(4,6) CE(5,7) CE(8,10) CE(9,11) CE(12,14) CE(13,15) CE(0,1) CE(2,3) CE(4,5) CE(6,7) CE(8,9) CE(10,11) CE(12,13) CE(14,15)

__device__ __forceinline__ void ce_desc(unsigned& a, unsigned& b) { const unsigned hi = a > b ? a : b, lo = a > b ? b : a; a = hi; b = lo; }
__device__ __forceinline__ void phase7(const Frame& F, const Args& a) {
    const unsigned* SC = (const unsigned*)(a.ws + WS_SC); int* IDX = (int*)(a.ws + WS_IDX); float* GWT = (float*)(a.ws + WS_GW);
    LAS unsigned* stg = (LAS unsigned*)(F.lds + F.wave * 16384);
    LAS unsigned* lst0 = (LAS unsigned*)(F.lds + F.wave * 16384 + 8448);
    const int lane = F.lane;
    const float* pu = a.in[17]; const float* pv = a.in[18]; unsigned char* U8 = a.ws + WS_U8; unsigned char* V8 = a.ws + WS_U8 + 128; int urow = F.gw;
    constexpr int NIT = T * 16 / 128;
    unsigned nx[32];
#define P7_FETCH(IT, ST) do { const size_t vb_ = (size_t)(IT) * 128; const int rnd_ = (ST) >> 1, cch_ = (ST) & 1; \
        _Pragma("unroll") for (int i = 0; i < 32; ++i) { const int row = 2 * i + (lane >> 5); nx[i] = __builtin_nontemporal_load(SC + (vb_ + rnd_ * 64 + row) * 64 + cch_ * 32 + (lane & 31)); } } while (0)
    if (F.gw < NIT) P7_FETCH(F.gw, 0);
    for (int it = F.gw; it < NIT; it += F.NGW) {
        const size_t vb = (size_t)it * 128;
        unsigned R[16];
#pragma unroll 1
        for (int st = 0; st < 4; ++st) {
            const int rnd = st >> 1, cch = st & 1;
            {
#pragma unroll
                for (int i = 0; i < 32; ++i) { const int row = 2 * i + (lane >> 5); stg[row * 33 + (lane & 31)] = nx[i]; }
                { int nit = it, nst = st + 1; if (nst == 4) { nst = 0; nit = it + F.NGW; }
                  if (nit < NIT) P7_FETCH(nit, nst); }
                f32x4 ux[4], vx[4]; const bool uok = urow < NEXP;
                if (uok) {
#pragma unroll
                    for (int q = 0; q < 4; ++q) { ux[q] = __builtin_nontemporal_load((const GAS f32x4*)(pu + (size_t)urow * 1024 + 256 * q + 4 * lane)); vx[q] = __builtin_nontemporal_load((const GAS f32x4*)(pv + (size_t)urow * 1024 + 256 * q + 4 * lane)); } }
                LDS_WAIT(); asm volatile("" ::: "memory");
#pragma unroll
                for (int hf = 0; hf < 4; ++hf) {
                    unsigned G[16];
#pragma unroll
                    for (int k = 0; k < 8; ++k) { const unsigned w = stg[lane * 33 + hf * 8 + k]; const unsigned i0 = 127u - (unsigned)(cch * 64 + hf * 16 + 2 * k);
                        G[2 * k] = (w << 16) ^ (0x80000000u | i0); G[2 * k + 1] = (w & 0xFFFF0000u) ^ (0x80000000u | (i0 - 1u)); }
#define CEG(x, y) ce_desc(G[x], G[y]);
                    SORT16_NET(CEG)
#undef CEG
                    if (cch == 0 && hf == 0) {
#pragma unroll
                        for (int k = 0; k < 16; ++k) R[k] = G[k]; }
                    else {
#pragma unroll
                        for (int k = 0; k < 16; ++k) R[k] = R[k] > G[15 - k] ? R[k] : G[15 - k];
#define CER(x, y) ce_desc(R[x], R[y]);
                        BITONIC16_NET(CER)
#undef CER
                    }
                }
                LDS_WAIT(); asm volatile("" ::: "memory");
                if (uok) {
#pragma unroll
                    for (int q = 0; q < 4; ++q) { tab_store_i8(U8, urow, q, lane, ux[q], USCALE); tab_store_i8(V8, urow, q, lane, vx[q], VSCALE); } }
                urow += F.NGW;
            }
            if (cch == 1) {
                LAS unsigned* dst = rnd == 0 ? lst0 : stg;
#pragma unroll
                for (int k = 0; k < 16; ++k) dst[lane * 17 + k] = R[k];
            }
        }
        LDS_WAIT(); asm volatile("" ::: "memory");
        const LAS unsigned* my = ((lane < 32) ? lst0 : stg) + (2 * (lane & 31)) * 17;
        int s0[16], s1[16];
#pragma unroll
        for (int i = 0; i < 16; ++i) { s0[i] = (int)(my[i] >> 16); s1[i] = (int)(my[17 + i] >> 16); }
#define PKEY(I, J) ((((unsigned)(s0[I] + s1[J])) << 8) | (unsigned)(255 - ((I) * 16 + (J))))
        unsigned M[16];
#pragma unroll
        for (int j = 0; j < 16; ++j) M[j] = PKEY(0, j);
#define CEM(x, y) ce_desc(M[x], M[y]);
#define MERGE_ROW(I, R) do { _Pragma("unroll") for (int k = 0; k < (R); ++k) { const unsigned key_ = PKEY(I, k); M[15 - k] = M[15 - k] > key_ ? M[15 - k] : key_; } BITONIC16_NET(CEM) } while (0)
        MERGE_ROW(1, 8); MERGE_ROW(2, 5); MERGE_ROW(3, 4); MERGE_ROW(4, 3); MERGE_ROW(5, 2); MERGE_ROW(6, 2); MERGE_ROW(7, 2);
        {
#pragma unroll
            for (int k = 0; k < 8; ++k) { const unsigned key_ = PKEY(8 + k, 0); M[15 - k] = M[15 - k] > key_ ? M[15 - k] : key_; }
            BITONIC16_NET(CEM)
        }
#undef MERGE_ROW
#undef CEM
#undef PKEY
        float bv[16]; int ev[16];
#pragma unroll
        for (int q = 0; q < 16; ++q) { const unsigned ij = 255u - (M[q] & 255u); const unsigned ka = my[ij >> 4], kb = my[17 + (ij & 15u)];
            bv[q] = (float)((int)(M[q] >> 8) - (int)(M[0] >> 8)) * (1.f / 2048.f);
            ev[q] = (int)((127u - (ka & 127u)) * 128u + (127u - (kb & 127u))); }
        float sum = 0.f;
#pragma unroll
        for (int q = 0; q < 16; ++q) { bv[q] = expf(bv[q]); sum += bv[q]; }
        const float inv = 1.f / sum;
        const size_t id = vb / 2 + lane;
        GAS v4u* oi = (GAS v4u*)(IDX + id * 8); GAS f32x4* og = (GAS f32x4*)(GWT + id * 16);
#pragma unroll
        for (int q = 0; q < 2; ++q) oi[q] = (v4u){(unsigned)ev[8 * q] | ((unsigned)ev[8 * q + 1] << 16), (unsigned)ev[8 * q + 2] | ((unsigned)ev[8 * q + 3] << 16),
                                                  (unsigned)ev[8 * q + 4] | ((unsigned)ev[8 * q + 5] << 16), (unsigned)ev[8 * q + 6] | ((unsigned)ev[8 * q + 7] << 16)};
#pragma unroll
        for (int q = 0; q < 4; ++q) og[q] = (f32x4){bv[4 * q] * inv, bv[4 * q + 1] * inv, bv[4 * q + 2] * inv, bv[4 * q + 3] * inv};
        LDS_WAIT(); asm volatile("" ::: "memory");
    }
    for (; urow < NEXP; urow += F.NGW) {
#pragma unroll
        for (int q = 0; q < 4; ++q) { tab_store_i8(U8, urow, q, lane, __builtin_nontemporal_load((const GAS f32x4*)(pu + (size_t)urow * 1024 + 256 * q + 4 * lane)), USCALE);
            tab_store_i8(V8, urow, q, lane, __builtin_nontemporal_load((const GAS f32x4*)(pv + (size_t)urow * 1024 + 256 * q + 4 * lane)), VSCALE); } }
}

__device__ __forceinline__ float gelu_erf(float v) { return 0.5f * v * (1.f + erff(v * 0.70710678118654752f)); }
__device__ __forceinline__ int sliced_vb(const Frame& F, const Args& a) {
    const gu32* cnt = (const gu32*)(a.ws + WS_CTL) + CW_XRANK; bool ok = (F.G == 256);
#pragma unroll
    for (int x = 0; x < 8; ++x) ok = ok && (__hip_atomic_load(cnt + 64 * x, __ATOMIC_RELAXED, __HIP_MEMORY_SCOPE_AGENT) == 32u);
    return ok ? (F.xrank * 8 + F.xcc) : (int)blockIdx.x;
}
typedef float f32x2v __attribute__((ext_vector_type(2)));
#define PEER_SWZ8(SW, W) do { SW[0] = (unsigned)__builtin_amdgcn_ds_swizzle((int)(W), 0x18 | (0 << 5)); SW[1] = (unsigned)__builtin_amdgcn_ds_swizzle((int)(W), 0x18 | (1 << 5)); \
    SW[2] = (unsigned)__builtin_amdgcn_ds_swizzle((int)(W), 0x18 | (2 << 5)); SW[3] = (unsigned)__builtin_amdgcn_ds_swizzle((int)(W), 0x18 | (3 << 5)); \
    SW[4] = (unsigned)__builtin_amdgcn_ds_swizzle((int)(W), 0x18 | (4 << 5)); SW[5] = (unsigned)__builtin_amdgcn_ds_swizzle((int)(W), 0x18 | (5 << 5)); \
    SW[6] = (unsigned)__builtin_amdgcn_ds_swizzle((int)(W), 0x18 | (6 << 5)); SW[7] = (unsigned)__builtin_amdgcn_ds_swizzle((int)(W), 0x18 | (7 << 5)); } while (0)
#define PEER_GATHER(Q, BASE, COFF, SW) do { __builtin_amdgcn_s_setprio(1); _Pragma("unroll") for (int j_ = 0; j_ < 8; ++j_) { \
    Q[2 * j_] = *(const GAS v4u*)((BASE) + __builtin_amdgcn_perm(SW[j_], (COFF), 0x0c050400u)); Q[2 * j_ + 1] = *(const GAS v4u*)((BASE) + __builtin_amdgcn_perm(SW[j_], (COFF), 0x0c070600u)); } __builtin_amdgcn_s_setprio(0); } while (0)
__device__ __forceinline__ void treduce16i_dpp210(const int (&d)[16], int lane, int& r0, int& r1) {
    const bool b2 = (lane >> 2) & 1, b1 = (lane >> 1) & 1, b0 = lane & 1;
    int e[8], f[4];
#pragma unroll
    for (int k = 0; k < 8; ++k) { const int mine = b2 ? d[k + 8] : d[k], theirs = b2 ? d[k] : d[k + 8]; e[k] = mine + __builtin_amdgcn_update_dpp(0, theirs, 0x141, 0xf, 0xf, false); }
#pragma unroll
    for (int k = 0; k < 4; ++k) { const int mine = b1 ? e[k + 4] : e[k], theirs = b1 ? e[k] : e[k + 4]; f[k] = mine + __builtin_amdgcn_update_dpp(0, theirs, 0x4E, 0xf, 0xf, false); }
    { const int m0 = b0 ? f[2] : f[0], t0 = b0 ? f[0] : f[2]; r0 = m0 + __builtin_amdgcn_update_dpp(0, t0, 0xB1, 0xf, 0xf, false);
      const int m1 = b0 ? f[3] : f[1], t1 = b0 ? f[1] : f[3]; r1 = m1 + __builtin_amdgcn_update_dpp(0, t1, 0xB1, 0xf, 0xf, false); }
}
__device__ __forceinline__ void treduce16i_swap543(const int (&d)[16], int lane, int& r0, int& r1) {
    const bool b0 = (lane >> 3) & 1;
    int e[8], f[4];
#pragma unroll
    for (int k = 0; k < 8; ++k) { const auto s = __builtin_amdgcn_permlane32_swap((unsigned)d[k], (unsigned)d[k + 8], false, false); e[k] = (int)(s[0] + s[1]); }
#pragma unroll
    for (int k = 0; k < 4; ++k) { const auto s = __builtin_amdgcn_permlane16_swap((unsigned)e[k], (unsigned)e[k + 4], false, false); f[k] = (int)(s[0] + s[1]); }
    { const int m0 = b0 ? f[2] : f[0], t0 = b0 ? f[0] : f[2]; r0 = m0 + __builtin_amdgcn_update_dpp(0, t0, 0x128, 0xf, 0xf, false);
      const int m1 = b0 ? f[3] : f[1], t1 = b0 ? f[1] : f[3]; r1 = m1 + __builtin_amdgcn_update_dpp(0, t1, 0x128, 0xf, 0xf, false); }
}
__device__ __forceinline__ int dot16_i8(const v4u& q, const v4u& h) {
    int s = __builtin_amdgcn_sdot4((int)q.x, (int)h.x, 0, false); s = __builtin_amdgcn_sdot4((int)q.y, (int)h.y, s, false);
    s = __builtin_amdgcn_sdot4((int)q.z, (int)h.z, s, false); return __builtin_amdgcn_sdot4((int)q.w, (int)h.w, s, false);
}
__device__ __forceinline__ void phase8(const Frame& F, const Args& a) {
    unsigned char* ws = a.ws;
    const unsigned char* H8 = ws + WS_H8; const float* HS = (const float*)(ws + WS_HS); const unsigned char* U8 = ws + WS_U8; const int* IDX = (const int*)(ws + WS_IDX); bf16* PART = (bf16*)(ws + WS_PART);
    const int lane = F.lane, g = lane >> 3, c = lane & 7;
    for (int vb = __builtin_amdgcn_readfirstlane(sliced_vb(F, a)); vb < 256; vb += F.G) {
        const int slice = vb & 7, tbase = (vb >> 3) * 1024 + F.wave * 128;
        const unsigned char* Us = U8 + (size_t)slice * ((size_t)NEXP * 256); const unsigned coff = (unsigned)c * 16u;
        const GAS unsigned* ipb = (const GAS unsigned*)IDX + (size_t)tbase * 64 + lane;
        const GAS unsigned* hpb = (const GAS unsigned*)(H8 + (size_t)tbase * 1024 + slice * 128) + (4 * c + (g & 3));
        bf16* pout = PART + ((size_t)slice * T + tbase) * 128 + 16 * g + 2 * c;
        v4u qA[16], qB[16], hsA, hsB; unsigned sw[8];
#define P8_SWZ(W, J) ((unsigned)__builtin_amdgcn_ds_swizzle((int)(W), 0x07 | ((J) << 8)))
#define P8_HSWZ(HS_, HW) do { HS_ = (v4u){P8_SWZ(HW, 0), P8_SWZ(HW, 1), P8_SWZ(HW, 2), P8_SWZ(HW, 3)}; } while (0)
#define P8_MATH(Q, HV, TI) do { int d[16]; _Pragma("unroll") for (int k = 0; k < 16; ++k) d[k] = dot16_i8(Q[k], HV); \
            int r0, r1; treduce16i_dpp210(d, lane, r0, r1); \
            *(GAS unsigned*)(pout + (size_t)(TI) * 128) = pk2((float)r0, (float)r1); } while (0)
#define P8_TOK(X) ((X) < 127 ? (X) : 127)
        unsigned iw = ipb[0], hw = hpb[0];
        PEER_SWZ8(sw, iw); P8_HSWZ(hsA, hw); PEER_GATHER(qA, Us, coff, sw);
        iw = ipb[64]; hw = hpb[256];
        PEER_SWZ8(sw, iw); P8_HSWZ(hsB, hw);
        iw = ipb[2 * 64]; hw = hpb[2 * 256];
        for (int i = 0; i < 128; i += 2) {
            PEER_GATHER(qB, Us, coff, sw);
            PEER_SWZ8(sw, iw); iw = ipb[P8_TOK(i + 3) * 64];
            P8_MATH(qA, hsA, i);
            P8_HSWZ(hsA, hw); hw = hpb[P8_TOK(i + 3) * 256];
            if (i + 2 < 128) PEER_GATHER(qA, Us, coff, sw);
            PEER_SWZ8(sw, iw); iw = ipb[P8_TOK(i + 4) * 64];
            P8_MATH(qB, hsB, i + 1);
            P8_HSWZ(hsB, hw); hw = hpb[P8_TOK(i + 4) * 256];
        }
#undef P8_HSWZ
#undef P8_TOK
#undef P8_MATH
    }
}
__device__ __forceinline__ void phase9(const Frame& F, const Args& a) {
    unsigned char* ws = a.ws;
    const bf16* PART = (const bf16*)(ws + WS_PART); const float* GWT = (const float*)(ws + WS_GW); unsigned char* W8 = ws + WS_W; float* WSC = (float*)(ws + WS_WSC); const float* HS = (const float*)(ws + WS_HS);
    const size_t n8 = (size_t)T * 128 / 8;
    for (size_t i = (size_t)F.vcu * 512 + F.tid; i < n8; i += (size_t)F.G * 512) {
        float s[8];
#pragma unroll
        for (int k = 0; k < 8; ++k) s[k] = 0.f;
#pragma unroll
        for (int x = 0; x < 8; ++x) { const v4u q = __builtin_nontemporal_load((const GAS v4u*)(PART + (size_t)x * T * 128 + i * 8));
            s[0] += bflo(q.x); s[1] += bfhi(q.x); s[2] += bflo(q.y); s[3] += bfhi(q.y); s[4] += bflo(q.z); s[5] += bfhi(q.z); s[6] += bflo(q.w); s[7] += bfhi(q.w); }
        const f32x4 g0 = __builtin_nontemporal_load((const GAS f32x4*)(GWT + i * 8)), g1 = __builtin_nontemporal_load((const GAS f32x4*)(GWT + i * 8 + 4));
        { const float hs_ = HS[i >> 4] * (1.f / USCALE);
#pragma unroll
          for (int k = 0; k < 8; ++k) s[k] *= hs_; }
        float o[8]; float mx = 0.f;
#pragma unroll
        for (int k = 0; k < 4; ++k) { o[k] = g0[k] * gelu_erf(s[k]); o[4 + k] = g1[k] * gelu_erf(s[4 + k]); }
#pragma unroll
        for (int k = 0; k < 8; ++k) mx = fmaxf(mx, fabsf(o[k]));
        mx = row16_max(mx);
        mx = fmaxf(mx, 1e-30f); const float inv = 127.f / mx;
        const unsigned w0 = q8x4(o[0], o[1], o[2], o[3], inv), w1 = q8x4(o[4], o[5], o[6], o[7], inv);
        typedef unsigned u32x2v __attribute__((ext_vector_type(2)));
        *(GAS u32x2v*)(W8 + i * 8) = (u32x2v){w0, w1};
        if ((F.lane & 15) == 0) WSC[i >> 4] = mx * (1.f / 127.f);
    }
}
__device__ __forceinline__ void tr4x4(unsigned a, unsigned b, unsigned c, unsigned d, unsigned (&o)[4]) {
    const unsigned x0 = __builtin_amdgcn_perm(b, a, 0x05010400u), x1 = __builtin_amdgcn_perm(b, a, 0x07030602u);
    const unsigned y0 = __builtin_amdgcn_perm(d, c, 0x05010400u), y1 = __builtin_amdgcn_perm(d, c, 0x07030602u);
    o[0] = __builtin_amdgcn_perm(y0, x0, 0x05040100u); o[1] = __builtin_amdgcn_perm(y0, x0, 0x07060302u);
    o[2] = __builtin_amdgcn_perm(y1, x1, 0x05040100u); o[3] = __builtin_amdgcn_perm(y1, x1, 0x07060302u);
}
__device__ __forceinline__ void phase10(const Frame& F, const Args& a) {
    unsigned char* ws = a.ws;
    const unsigned char* V8 = ws + WS_U8 + 128; const int* IDX = (const int*)(ws + WS_IDX); const unsigned char* W8 = ws + WS_W; const float* WSC = (const float*)(ws + WS_WSC);
    bf16* Y = (bf16*)(ws + WS_Y);
    const int lane = F.lane, g = lane >> 3, c = lane & 7;
    for (int vb = __builtin_amdgcn_readfirstlane(sliced_vb(F, a)); vb < 256; vb += F.G) {
        const int slice = vb & 7, tbase = (vb >> 3) * 1024 + F.wave * 128;
        const unsigned char* Vs = V8 + (size_t)slice * ((size_t)NEXP * 256); const unsigned coff = (unsigned)c * 16u;
        const GAS unsigned* ipb = (const GAS unsigned*)IDX + (size_t)tbase * 64 + lane;
        const GAS unsigned* wpb = (const GAS unsigned*)(W8 + (size_t)tbase * 128) + (4 * g + (c & 3));
        const int col = slice * 128 + 16 * c + 2 * g;
        GAS unsigned* ypb = (GAS unsigned*)(Y + (size_t)tbase * 1024 + col);
        v4u qA[16], qB[16], wsA, wsB; unsigned sw[8];
#define P10_RG(Q, RG, WQ) do { unsigned t_[4]; \
            tr4x4(Q[4 * RG].x, Q[4 * RG + 1].x, Q[4 * RG + 2].x, Q[4 * RG + 3].x, t_); _Pragma("unroll") for (int j = 0; j < 4; ++j) d[j] = __builtin_amdgcn_sdot4((int)t_[j], (int)(WQ), d[j], false); \
            tr4x4(Q[4 * RG].y, Q[4 * RG + 1].y, Q[4 * RG + 2].y, Q[4 * RG + 3].y, t_); _Pragma("unroll") for (int j = 0; j < 4; ++j) d[4 + j] = __builtin_amdgcn_sdot4((int)t_[j], (int)(WQ), d[4 + j], false); \
            tr4x4(Q[4 * RG].z, Q[4 * RG + 1].z, Q[4 * RG + 2].z, Q[4 * RG + 3].z, t_); _Pragma("unroll") for (int j = 0; j < 4; ++j) d[8 + j] = __builtin_amdgcn_sdot4((int)t_[j], (int)(WQ), d[8 + j], false); \
            tr4x4(Q[4 * RG].w, Q[4 * RG + 1].w, Q[4 * RG + 2].w, Q[4 * RG + 3].w, t_); _Pragma("unroll") for (int j = 0; j < 4; ++j) d[12 + j] = __builtin_amdgcn_sdot4((int)t_[j], (int)(WQ), d[12 + j], false); } while (0)
#define P10_SWZ(W, J) ((unsigned)__builtin_amdgcn_ds_swizzle((int)(W), 0x18 | ((J) << 5)))
#define P10_WSWZ(WS_, WW) do { WS_ = (v4u){P10_SWZ(WW, 0), P10_SWZ(WW, 1), P10_SWZ(WW, 2), P10_SWZ(WW, 3)}; } while (0)
#define P10_MATH(Q, WV, TI) do { int d[16]; _Pragma("unroll") for (int k = 0; k < 16; ++k) d[k] = 0; \
            P10_RG(Q, 0, WV.x); P10_RG(Q, 1, WV.y); P10_RG(Q, 2, WV.z); P10_RG(Q, 3, WV.w); \
            int r0, r1; treduce16i_swap543(d, lane, r0, r1); \
            ypb[(size_t)(TI) * 512] = pk2((float)r0, (float)r1); } while (0)
#define P10_TOK(X) ((X) < 127 ? (X) : 127)
        unsigned iw = ipb[0], ww = wpb[0];
        PEER_SWZ8(sw, iw); P10_WSWZ(wsA, ww); PEER_GATHER(qA, Vs, coff, sw);
        iw = ipb[64]; ww = wpb[32];
        PEER_SWZ8(sw, iw); P10_WSWZ(wsB, ww);
        iw = ipb[2 * 64]; ww = wpb[2 * 32];
        for (int i = 0; i < 128; i += 2) {
            PEER_GATHER(qB, Vs, coff, sw);
            PEER_SWZ8(sw, iw); iw = ipb[P10_TOK(i + 3) * 64];
            P10_MATH(qA, wsA, i);
            P10_WSWZ(wsA, ww); ww = wpb[P10_TOK(i + 3) * 32];
            if (i + 2 < 128) PEER_GATHER(qA, Vs, coff, sw);
            PEER_SWZ8(sw, iw); iw = ipb[P10_TOK(i + 4) * 64];
            P10_MATH(qB, wsB, i + 1);
            P10_WSWZ(wsB, ww); ww = wpb[P10_TOK(i + 4) * 32];
        }
#undef P10_WSWZ
#undef P10_TOK
#undef P10_RG
#undef P10_MATH
    }
}
__device__ __forceinline__ void phase11(const Frame& F, const Args& a) {
    const bf16* Y = (const bf16*)(a.ws + WS_Y); const bf16* X1 = (const bf16*)(a.ws + WS_H); const float* MOD = (const float*)(a.ws + WS_MOD); const float* WSC = (const float*)(a.ws + WS_WSC); float* O = a.out; const float* fg = a.in[19];
    f32x4 fgv[4];
#pragma unroll
    for (int j = 0; j < 4; ++j) fgv[j] = *(const f32x4*)(fg + 4 * F.lane + 256 * j);
    for (int t = F.gw; t < T; t += F.NGW) {
        const GAS unsigned long long* yr = (const GAS unsigned long long*)(Y + (size_t)t * 1024) + F.lane;
        const GAS unsigned long long* dr = (const GAS unsigned long long*)(X1 + (size_t)t * 1024) + F.lane;
        const float* g2p = MOD + (size_t)(t >> 11) * 6144 + 5120 + 4 * F.lane; const float ysc = WSC[t] * (1.f / VSCALE);
        f32x4 v[4]; float ss = 0.f;
#pragma unroll
        for (int j = 0; j < 4; ++j) { const unsigned long long yy = __builtin_nontemporal_load(yr + 64 * j), dd = __builtin_nontemporal_load(dr + 64 * j); const f32x4 gg = *(const f32x4*)(g2p + 256 * j) * ysc;
            const unsigned ylo = (unsigned)yy, yhi = (unsigned)(yy >> 32), dlo = (unsigned)dd, dhi = (unsigned)(dd >> 32);
            v[j] = (f32x4){bflo(dlo) + gg[0] * bflo(ylo), bfhi(dlo) + gg[1] * bfhi(ylo), bflo(dhi) + gg[2] * bflo(yhi), bfhi(dhi) + gg[3] * bfhi(yhi)};
            ss += (v[j][0] * v[j][0] + v[j][1] * v[j][1]) + (v[j][2] * v[j][2] + v[j][3] * v[j][3]); }
        ss = wave_sum(ss);
        const float r = 1.f / sqrtf(ss * (1.f / 1024.f) + EPS);
        GAS f32x4* orow = (GAS f32x4*)(O + (size_t)t * 1024) + F.lane;
#pragma unroll
        for (int j = 0; j < 4; ++j) __builtin_nontemporal_store(v[j] * r * fgv[j], orow + 64 * j);
    }
}
__global__ void __launch_bounds__(NWAVES * 64, 2) mk_fwd(Args args) {
    extern __shared__ __attribute__((aligned(16))) unsigned char lds[];
    Frame F;
    F.lds = (LAS unsigned char*)lds; F.ldsg = lds;
    F.tid = threadIdx.x; F.lane = F.tid & 63; F.wave = __builtin_amdgcn_readfirstlane(F.tid >> 6);
    F.G = gridDim.x; { const int bx = blockIdx.x; F.vcu = (F.G % 8 == 0) ? (bx % 8) * (F.G / 8) + bx / 8 : bx; }
    F.gw = F.vcu * NWAVES + F.wave; F.NGW = F.G * NWAVES;
    volatile LAS unsigned* MISC = (volatile LAS unsigned*)(F.lds + MISC_OFF);
    unsigned char* ws = args.ws;
    gu32* ctl = (gu32*)(ws + WS_CTL);
    for (int u = F.tid; u < (LDS_BYTES - LDSCTL_OFF) / 4; u += NWAVES * 64) ((LAS unsigned*)(F.lds + LDSCTL_OFF))[u] = 0u;
    __syncthreads();
    const int lo = args.ph_lo, hi = args.ph_hi;
    if (F.tid == 0) { const unsigned x = xb_xcc_id() & 7u; MISC[16] = x; MISC[17] = __hip_atomic_fetch_add((unsigned*)(ctl + CW_XRANK) + 64 * x, 1u, __ATOMIC_RELAXED, __HIP_MEMORY_SCOPE_AGENT); }
    __syncthreads();
    F.xcc = (int)MISC[16]; F.xrank = (int)MISC[17];
    XcdBarrier bar; bar.bar = (unsigned*)(ctl + CW_BAR) + args.li * XCD_BAR_WORDS; bar.x = 0; bar.st = nullptr;
    if (hi - lo > 1) bar = xcd_barrier_post((unsigned*)(ctl + CW_BAR) + args.li * XCD_BAR_WORDS, MISC + 8);
#ifndef PHASE_MASK
#define PHASE_MASK 0xfff
#endif
#define IN(k) (((PHASE_MASK >> (k)) & 1) && lo <= (k) && (k) < hi)
#define SEAM(k) do { if (IN(k) && IN((k) + 1)) xcd_barrier(bar); } while (0)
#ifndef REP_MASK
#define REP_MASK 0
#endif
#ifndef GREP1
#define GREP1 1
#endif
#ifndef GREP2
#define GREP2 1
#endif
#ifndef GREP3
#define GREP3 1
#endif
#define NREP(k) (((REP_MASK >> (k)) & 1) ? 2 : 1)

#ifdef EXTRA_BARRIERS
    if (hi - lo > 1) for (int xb_ = 0; xb_ < EXTRA_BARRIERS; ++xb_) xcd_barrier(bar);
#endif
    if (IN(0)) for (int rep_ = 0; rep_ < NREP(0); ++rep_) { phase0(F, args); } SEAM(0);
    if (IN(1)) for (int rep_ = 0; rep_ < NREP(1); ++rep_) { __syncthreads(); phase1(F, args); } SEAM(1);
    if (IN(2)) for (int rep_ = 0; rep_ < NREP(2); ++rep_) { __syncthreads();
        pg8::Gemm g{(const pg8::bf16_t*)(ws + WS_H8), (const pg8::bf16_t*)(ws + WS_WIN), T, IN_COLS, DM / 2}; pg8::StaticOrder S; S.init(T, IN_COLS, F.G, (int)blockIdx.x, GREP1);
        pg8::EpiPI E{(pg8::bf16_t*)(ws + WS_Q), (pg8::bf16_t*)(ws + WS_K), (pg8::bf16_t*)(ws + WS_VV), (pg8::bf16_t*)(ws + WS_CB), (pg8::bf16_t*)(ws + WS_GC), 0.125f * 1.4426950408889634f, (const float*)(ws + WS_HS), (const float*)(ws + WS_WINS), (unsigned*)(ctl + CW_KN)};
        pg8::gemm_phase<pg8::EpiPI, pg8::StaticOrder, true, true, true>(F.lds, g, S, E); } SEAM(2);
    if (IN(3)) for (int rep_ = 0; rep_ < NREP(3); ++rep_) { __syncthreads(); phase3(F, args); } SEAM(3);
    if (IN(4)) for (int rep_ = 0; rep_ < NREP(4); ++rep_) { __syncthreads();
        pg8::Gemm g{(const pg8::bf16_t*)(ws + WS_MIX), (const pg8::bf16_t*)(ws + WS_WO), T, DM, DM}; pg8::StaticOrder S; S.init(T, DM, F.G, (int)blockIdx.x, GREP2);
        pg8::EpiGate E{(pg8::bf16_t*)(ws + WS_DELTA), (const float*)(ws + WS_MOD)};
        pg8::gemm_phase<pg8::EpiGate, pg8::StaticOrder, true, true>(F.lds, g, S, E); } SEAM(4);
    if (IN(5)) for (int rep_ = 0; rep_ < NREP(5); ++rep_) { __syncthreads(); norm_rows<false, true, true>(F, args.in[0], (const bf16*)(ws + WS_DELTA), (bf16*)(ws + WS_H), (unsigned*)(ws + WS_H8), (float*)(ws + WS_HS), args.in[14], (const float*)(ws + WS_MOD), nullptr, 3072, 4096); } SEAM(5);
    if (IN(6)) for (int rep_ = 0; rep_ < NREP(6); ++rep_) { __syncthreads();
        pg8::Gemm g{(const pg8::bf16_t*)(ws + WS_H8), (const pg8::bf16_t*)(ws + WS_WK), T, 2048, DM / 2}; pg8::StaticOrder S; S.init(T, 2048, F.G, (int)blockIdx.x, GREP3);
        pg8::EpiS16I E{(short*)(ws + WS_SC), 2048, (const float*)(ws + WS_HS), (const float*)(ws + WS_WKS)};
        pg8::gemm_phase<pg8::EpiS16I, pg8::StaticOrder, true, true, true>(F.lds, g, S, E); } SEAM(6);
    if (IN(7)) for (int rep_ = 0; rep_ < NREP(7); ++rep_) { __syncthreads(); phase7(F, args); } SEAM(7);
    if (IN(8)) for (int rep_ = 0; rep_ < NREP(8); ++rep_) { __syncthreads(); phase8(F, args); } SEAM(8);
    if (IN(9)) for (int rep_ = 0; rep_ < NREP(9); ++rep_) { __syncthreads(); phase9(F, args); } SEAM(9);
    if (IN(10)) for (int rep_ = 0; rep_ < NREP(10); ++rep_) { __syncthreads(); phase10(F, args); } SEAM(10);
    if (IN(11)) for (int rep_ = 0; rep_ < NREP(11); ++rep_) { __syncthreads(); phase11(F, args); }
#undef IN
#undef SEAM
}

extern "C" void kernel_launch(void* const* d_in, const int* in_sizes, int n_in, void* d_out, int out_size, void* d_ws, size_t ws_size, hipStream_t stream) {
    static int grid = 0;
    if (grid == 0) {
        if (n_in != 20 || in_sizes[0] != T * DM || out_size != T * DM || ws_size < WS_END) {
            fprintf(stderr, "kernel_launch: built for 20 inputs, x/out of %d floats, >= %zu bytes of workspace; got n_in %d, in0 %d, out %d, ws %zu; nothing launched\n", T * DM, (size_t)WS_END, n_in, n_in > 0 ? in_sizes[0] : -1, out_size, ws_size);
            grid = -1; return; }
        int dev = 0, cus = 0, per_cu = 0;
        if (hipGetDevice(&dev) != hipSuccess || hipDeviceGetAttribute(&cus, hipDeviceAttributeMultiprocessorCount, dev) != hipSuccess) { fprintf(stderr, "kernel_launch: device query failed\n"); grid = -1; return; }
        if (hipFuncSetAttribute((const void*)mk_fwd, hipFuncAttributeMaxDynamicSharedMemorySize, LDS_BYTES) != hipSuccess) { fprintf(stderr, "kernel_launch: hipFuncSetAttribute failed\n"); grid = -1; return; }
        if (hipOccupancyMaxActiveBlocksPerMultiprocessor(&per_cu, (const void*)mk_fwd, NWAVES * 64, LDS_BYTES) != hipSuccess || per_cu < 1) {
            fprintf(stderr, "kernel_launch: occupancy query reports %d workgroups per CU; nothing launched\n", per_cu); (void)hipGetLastError(); grid = -1; return; }
        grid = cus;
    }
    if (grid < 0) return;
    if (hipMemsetAsync((char*)d_ws + WS_CTL, 0, CTL_ZERO_BYTES, stream) != hipSuccess) { fprintf(stderr, "kernel_launch: memset failed\n"); return; }
    Args a{};
    for (int i = 0; i < 20; ++i) a.in[i] = (const float*)d_in[i];
    a.out = (float*)d_out; a.ws = (unsigned char*)d_ws;
    if (N_LAUNCHES == 1) { a.ph_lo = 0; a.ph_hi = N_PHASES; a.li = 0; hipLaunchKernelGGL(mk_fwd, dim3(grid), dim3(NWAVES * 64), LDS_BYTES, stream, a); }
    else { for (int p = 0; p < N_PHASES; ++p) { a.ph_lo = p; a.ph_hi = p + 1; a.li = 0; hipLaunchKernelGGL(mk_fwd, dim3(grid), dim3(NWAVES * 64), LDS_BYTES, stream, a); } }
    const hipError_t le = hipPeekAtLastError();
    if (le != hipSuccess) fprintf(stderr, "kernel_launch: launch failed: %s\n", hipGetErrorName(le));
}
```
